# Optimizing an MI355X kernel written in HIP

```python
import jax, jax.numpy as jnp
from jax import lax
import numpy as np

D_MODEL = 4096
BATCH = 1
SEQ = 16384
DEPTH = 1
DEC_BATCH = 32
DEC_SEQ = 64
PAST_LEN = 4096

CHUNK = 64
SGU_CHUNK = 128
A_WIDTH = D_MODEL // 2
A_HEADS = 16
A_HEAD_DIM = A_WIDTH // A_HEADS
B_WIDTH = D_MODEL - A_WIDTH
B_HEADS = 4
B_KEY_DIM = B_WIDTH // 2
B_HEAD_K = B_KEY_DIM // B_HEADS
B_HEAD_V = B_WIDTH // B_HEADS
GATE_RANK = 16
GATE_TAU = 16.0
D_FF = -(-8 * D_MODEL // (3 * 256)) * 256
EPS = 1e-6
IN_COLS = 2 * A_WIDTH + 2 * B_KEY_DIM + 2 * B_WIDTH + GATE_RANK

kernel_name = "hybrid_sgu_gla_stream_step"


def rmsnorm(x, g):
    xf = x.astype(jnp.float32)
    y = xf * lax.rsqrt(jnp.mean(xf * xf, axis=-1, keepdims=True) + EPS)
    return (y * g.astype(jnp.float32)).astype(x.dtype)


def layernorm(x, g, b):
    xf = x.astype(jnp.float32)
    mu = jnp.mean(xf, axis=-1, keepdims=True)
    var = jnp.mean(jnp.square(xf - mu), axis=-1, keepdims=True)
    y = (xf - mu) * lax.rsqrt(var + EPS) * g.astype(jnp.float32) + b.astype(jnp.float32)
    return y.astype(x.dtype)


def sgu(z_u, z_v, w_s, b_s, ln_g, ln_b):
    bsz, L, _ = z_u.shape
    c = min(SGU_CHUNK, L)
    n = L // c
    v_n = layernorm(z_v, ln_g, ln_b)
    vv = v_n.reshape(bsz, n, c, A_HEADS, A_HEAD_DIM)
    w = w_s[:, :c, :c] * jnp.tril(jnp.ones((c, c), w_s.dtype))
    mixed = jnp.einsum('hij,bnjhd->bnihd', w, vv) + b_s[:, :c].T[None, None, :, :, None]
    return z_u * mixed.reshape(bsz, L, A_WIDTH), v_n


def gla(q, k, v, log_a, S0):
    bsz, L, H, dk = q.shape
    dv = v.shape[-1]
    c = min(CHUNK, L)
    n = L // c

    def to_blocks(t):
        return t.reshape(bsz, n, c, H, t.shape[-1]).transpose(1, 0, 3, 2, 4)

    mask = jnp.tril(jnp.ones((c, c), dtype=bool))
    ref = c // 2

    def step(S, inp):
        qc, kc, vc, gc = inp
        b = jnp.cumsum(gc, axis=2)
        b_ref = b[:, :, ref:ref + 1]
        b_last = b[:, :, -1:]
        att = jnp.einsum('bhid,bhjd->bhij', qc * jnp.exp(b - b_ref), kc * jnp.exp(b_ref - b))
        att = jnp.where(mask, att, 0.0)
        o = jnp.einsum('bhij,bhje->bhie', att, vc) + jnp.einsum('bhid,bhde->bhie', qc * jnp.exp(b), S)
        S_new = jnp.exp(b_last)[:, :, 0, :, None] * S + jnp.einsum('bhjd,bhje->bhde', kc * jnp.exp(b_last - b), vc)
        return S_new, o

    xs = (to_blocks(q), to_blocks(k), to_blocks(v), to_blocks(log_a))
    S_fin, o = lax.scan(step, S0.astype(jnp.float32), xs)
    o = o.transpose(1, 0, 3, 2, 4).reshape(bsz, L, H, dv)
    return o.astype(q.dtype), S_fin.astype(S0.dtype)


def mixer(h, S0, w_in, w_s, b_s, ln_g, ln_b, w_gate_up, b_gate, gla_norm_g, w_out):
    bsz, L, _ = h.shape
    proj = jnp.einsum('bld,de->ble', h, w_in)
    offs = np.cumsum([0, A_WIDTH, A_WIDTH, B_KEY_DIM, B_KEY_DIM, B_WIDTH, B_WIDTH, GATE_RANK])
    a_u, a_v, q, k, v, r, g_lr = [proj[..., int(offs[i]):int(offs[i + 1])] for i in range(7)]
    a_out, v_rows = sgu(jax.nn.gelu(a_u), jax.nn.gelu(a_v), w_s, b_s, ln_g, ln_b)
    q = q.reshape(bsz, L, B_HEADS, B_HEAD_K) * (B_HEAD_K ** -0.5)
    k = k.reshape(bsz, L, B_HEADS, B_HEAD_K)
    v = v.reshape(bsz, L, B_HEADS, B_HEAD_V)
    z = (jnp.einsum('blr,rk->blk', g_lr, w_gate_up) + b_gate).astype(jnp.float32)
    log_a = (jax.nn.log_sigmoid(z) / GATE_TAU).reshape(bsz, L, B_HEADS, B_HEAD_K)
    o, S_new = gla(q, k, v, log_a, S0)
    o = rmsnorm(o, gla_norm_g).reshape(bsz, L, B_WIDTH)
    b_out = o * jax.nn.silu(r)
    mix = jnp.einsum('ble,ed->bld', jnp.concatenate([a_out, b_out], axis=-1), w_out)
    return mix, v_rows, S_new


def swiglu(h, w_gate, w_up, w_down):
    return jnp.einsum('blf,fd->bld', jax.nn.silu(h @ w_gate) * (h @ w_up), w_down)


def trunk(x, states, g_mix, w_in, w_s, b_s, ln_g, ln_b, w_gate_up, b_gate, gla_norm_g, w_out,
          g_ffn, w_ffn_gate, w_ffn_up, w_ffn_down, g_final):
    new_states, v_rows_all = [], []
    for d in range(DEPTH):
        mix, v_rows, S_new = mixer(rmsnorm(x, g_mix[d]), states[d], w_in[d], w_s[d], b_s[d], ln_g[d],
                                   ln_b[d], w_gate_up[d], b_gate[d], gla_norm_g[d], w_out[d])
        x = x + mix
        x = x + swiglu(rmsnorm(x, g_ffn[d]), w_ffn_gate[d], w_ffn_up[d], w_ffn_down[d])
        new_states.append(S_new)
        v_rows_all.append(v_rows)
    return rmsnorm(x, g_final), jnp.stack(new_states), jnp.stack(v_rows_all)


def setup_inputs(seed: int = 0) -> dict:
    key = jax.random.key(seed)
    ks = jax.random.split(key, 24)
    nrm = lambda k, shape, s: jax.random.normal(k, shape, jnp.float32) * s
    return {
        "x_prompt": nrm(ks[0], (BATCH, SEQ, D_MODEL), 1.0),
        "x_sample": nrm(ks[1], (DEC_BATCH, DEC_SEQ, D_MODEL), 1.0),
        "state_gla": nrm(ks[2], (DEPTH, DEC_BATCH, B_HEADS, B_HEAD_K, B_HEAD_V), 0.5),
        "g_mix": 1.0 + nrm(ks[3], (DEPTH, D_MODEL), 0.02),
        "w_in": nrm(ks[4], (DEPTH, D_MODEL, IN_COLS), D_MODEL ** -0.5),
        "w_s": nrm(ks[5], (DEPTH, A_HEADS, SGU_CHUNK, SGU_CHUNK), SGU_CHUNK ** -0.5),
        "b_s": nrm(ks[6], (DEPTH, A_HEADS, SGU_CHUNK), 0.1),
        "ln_g": 1.0 + nrm(ks[7], (DEPTH, A_WIDTH), 0.02),
        "ln_b": nrm(ks[8], (DEPTH, A_WIDTH), 0.02),
        "w_gate_up": nrm(ks[9], (DEPTH, GATE_RANK, B_KEY_DIM), GATE_RANK ** -0.5),
        "b_gate": nrm(ks[10], (DEPTH, B_KEY_DIM), 0.1),
        "gla_norm_g": 1.0 + nrm(ks[11], (DEPTH, B_HEAD_V), 0.02),
        "w_out": nrm(ks[12], (DEPTH, D_MODEL, D_MODEL), D_MODEL ** -0.5),
        "g_ffn": 1.0 + nrm(ks[13], (DEPTH, D_MODEL), 0.02),
        "w_ffn_gate": nrm(ks[14], (DEPTH, D_MODEL, D_FF), D_MODEL ** -0.5),
        "w_ffn_up": nrm(ks[15], (DEPTH, D_MODEL, D_FF), D_MODEL ** -0.5),
        "w_ffn_down": nrm(ks[16], (DEPTH, D_FF, D_MODEL), D_FF ** -0.5),
        "g_final": 1.0 + nrm(ks[17], (D_MODEL,), 0.02),
    }


def reference(x_prompt, x_sample, state_gla, g_mix, w_in, w_s, b_s, ln_g, ln_b, w_gate_up, b_gate,
              gla_norm_g, w_out, g_ffn, w_ffn_gate, w_ffn_up, w_ffn_down, g_final):
    params = (g_mix, w_in, w_s, b_s, ln_g, ln_b, w_gate_up, b_gate, gla_norm_g, w_out,
              g_ffn, w_ffn_gate, w_ffn_up, w_ffn_down, g_final)
    zero_state = jnp.zeros((DEPTH, x_prompt.shape[0], B_HEADS, B_HEAD_K, B_HEAD_V), state_gla.dtype)
    y_prompt, new_gla_prompt, _ = trunk(x_prompt, zero_state, *params)
    y_sample, new_gla_sample, new_sgu_v_sample = trunk(x_sample, state_gla, *params)
    return (y_prompt, y_sample, new_gla_prompt, new_gla_sample, new_sgu_v_sample)
```

```cpp
#include <hip/hip_runtime.h>
#include <cstdio>
#include <cstdint>

namespace pg8 {
#define PG8_LAS __attribute__((address_space(3)))
typedef unsigned short bf16_t;
typedef short bf16x8 __attribute__((ext_vector_type(8)));
typedef float f32x4 __attribute__((ext_vector_type(4)));
typedef unsigned u32x4 __attribute__((ext_vector_type(4)));
typedef unsigned u32x2 __attribute__((ext_vector_type(2)));
constexpr int BM = 256, BK = 64, HALF = 128, HTB = HALF * BK * 2  , STAGE_BYTES = 8 * HTB, NXCD = 8, WGM = 8;

__host__ __device__ __forceinline__ int lds_byte(int r, int c) { const int st = (r >> 4) * 2 + (c >> 5), rr = r & 15, cc = c & 31, ob = rr * 64 + cc * 2; return st * 1024 + (ob ^ (((ob >> 9) & 1) << 5)); }
__host__ __device__ __forceinline__ void stage_rc(int b, int& R, int& C) { const int st = b / 1024, sb = b % 1024, swz = sb ^ (((sb >> 9) & 1) << 5); R = (st >> 1) * 16 + swz / 64; C = (st & 1) * 32 + (swz % 64) / 2; }
__host__ __device__ __forceinline__ int perm32(int rho) { const int n = rho >> 4, i = rho & 15; return 8 * (i >> 2) + 4 * n + (i & 3); }

struct Unit { int pm, pn, kp, tt; };
struct Gemm { const bf16_t* A; const bf16_t* Bt; int M, N, K; int ld = 0; };

struct StaticOrder {
    int nM, nN, nwg, G, c, wgm, imax;
    __host__ __device__ void init(int M, int N, int G_, int c_, int wgm_ = WGM) { nM = M / BM; nN = N / BM; nwg = nM * nN; G = G_; c = c_; wgm = wgm_; imax = 1 << 30; }
    __host__ __device__ void tile_of(long L, Unit& u) const {
        if (wgm < 0) { const int xcd = (int)(L % NXCD), off = (int)(L / NXCD), w = nN / NXCD; u.pm = off / w; u.pn = xcd * w + off % w; u.kp = 0; u.tt = 0; return; }
        int wgid = (int)L; { const int q = nwg / NXCD, r = nwg % NXCD, xcd = wgid % NXCD, off = wgid / NXCD; wgid = (xcd < r ? xcd * (q + 1) : r * (q + 1) + (xcd - r) * q) + off; }
        const int nig = wgm * nN, gid = wgid / nig, fm = gid * wgm, gsz = (nM - fm) < wgm ? (nM - fm) : wgm;
        u.pm = fm + ((wgid % nig) % gsz); u.pn = (wgid % nig) / gsz; u.kp = 0; u.tt = 0;
    }
    __host__ __device__ bool next(int i, Unit& u) const { const long L = (long)i * G + c; if (L >= nwg || i >= imax) return false; tile_of(L, u); return true; }
    __device__ __forceinline__ void a_ready(const Unit&) const {}
    __device__ __forceinline__ void done(const Unit&) const {}
};
struct TailOrder : StaticOrder {
    int base, T, P;
    __host__ __device__ bool next(int i, Unit& u) const { if (i > 0 || c >= T * P) return false; const int tt = c % T; tile_of((long)base + tt, u); u.kp = c / T; u.tt = tt; return true; }
};
__host__ __device__ __forceinline__ void split_plan(int nwg, int G, int maxP, int& rounds, int& T, int& P) { rounds = nwg / G; T = nwg - rounds * G; P = 1; if (T > 0) { const int q = G / T; P = q >= 4 ? 4 : (q >= 2 ? 2 : 1); if (P > maxP) P = maxP; } if (P < 2) { if (T > 0) ++rounds; T = 0; } }

__device__ __forceinline__ unsigned cvt_pk_bf16(float lo, float hi) { unsigned r; asm volatile("v_cvt_pk_bf16_f32 %0, %1, %2" : "=v"(r) : "v"(lo), "v"(hi)); return r; }
__device__ __forceinline__ float x_sigmoid(float x, float t) { return x * __builtin_amdgcn_rcpf(1.0f + __builtin_amdgcn_exp2f(-1.4426950408889634f * t)); }
__device__ __forceinline__ float gelu_tanh(float x) { const float u = 0.7978845608028654f * (x + 0.044715f * x * x * x); return x_sigmoid(x, 2.0f * u); }
__device__ __forceinline__ float silu_f(float x) { return x_sigmoid(x, x); }
template <int MODE> __device__ __forceinline__ float act_f(float x) { return MODE == 1 ? gelu_tanh(x) : (MODE == 2 ? x * 0.0625f : (MODE == 3 ? silu_f(x) : x)); }
__device__ __forceinline__ f32x4 x_sigmoid_v(f32x4 x, f32x4 t) {
    f32x4 e; e[0] = __builtin_amdgcn_exp2f(t[0]); e[1] = __builtin_amdgcn_exp2f(t[1]); e[2] = __builtin_amdgcn_exp2f(t[2]); e[3] = __builtin_amdgcn_exp2f(t[3]);
    const f32x4 d = e + 1.0f; f32x4 r; r[0] = __builtin_amdgcn_rcpf(d[0]); r[1] = __builtin_amdgcn_rcpf(d[1]); r[2] = __builtin_amdgcn_rcpf(d[2]); r[3] = __builtin_amdgcn_rcpf(d[3]);
    return x * r; }
template <int MODE> __device__ __forceinline__ f32x4 act_v(f32x4 x) {
    if (MODE == 1) { constexpr float K = -2.0f * 0.7978845608028654f * 1.4426950408889634f; return x_sigmoid_v(x, x * ((x * x) * (K * 0.044715f) + K)); }
    if (MODE == 3) return x_sigmoid_v(x, x * -1.4426950408889634f);
    if (MODE == 2) return x * 0.0625f;
    return x; }

struct EpiProj {
    static constexpr bool PERM = true, AFTER_DRAIN = false;
    bf16_t* P; float* glr; float* vst;
    template <int MODE, bool STATS> __device__ __forceinline__ void tile(const f32x4 (&acc)[2][2][4][2], int row0, int col0, int fq) const {
#pragma unroll
        for (int ai = 0; ai < 2; ++ai)
#pragma unroll
            for (int m = 0; m < 4; ++m) { const int row = row0 + ai * HALF + m * 16; bf16_t* rowp = P + (size_t)row * 10240 + col0; float s1 = 0.f, s2 = 0.f;
#pragma unroll
                for (int bj = 0; bj < 2; ++bj) { const f32x4 A0 = act_v<MODE>(acc[ai][bj][m][0]), A1 = act_v<MODE>(acc[ai][bj][m][1]); u32x4 w;
                    if (STATS) { const f32x4 p = A0 + A1, q = A0 * A0 + A1 * A1; s1 += (p[0] + p[1]) + (p[2] + p[3]); s2 += (q[0] + q[1]) + (q[2] + q[3]); }
                    w.x = cvt_pk_bf16(A0[0], A0[1]); w.y = cvt_pk_bf16(A0[2], A0[3]); w.z = cvt_pk_bf16(A1[0], A1[1]); w.w = cvt_pk_bf16(A1[2], A1[3]);
                    *(u32x4*)(rowp + bj * HALF) = w; }
                if (STATS) { s1 += __shfl_xor(s1, 16); s1 += __shfl_xor(s1, 32); s2 += __shfl_xor(s2, 16); s2 += __shfl_xor(s2, 32);
                    if (fq == 0) { atomicAdd(vst + 2 * row, s1); atomicAdd(vst + 2 * row + 1, s2); } } }
    }
    __device__ __forceinline__ void operator()(const f32x4 (&acc)[2][2][4][2], const Unit& u, int wr, int wc, int fr, int fq) const {
        asm volatile("s_nop 15" ::: "memory");
        const int row0 = u.pm * BM + wr * 64 + fr, colt = u.pn * BM;
        if (colt >= 10240) {
            if (wc == 0 && fq < 2) {
#pragma unroll
                for (int ai = 0; ai < 2; ++ai)
#pragma unroll
                    for (int m = 0; m < 4; ++m) { float* rp = glr + (size_t)(row0 + ai * HALF + m * 16) * 16 + 8 * fq; *(f32x4*)rp = acc[ai][0][m][0]; *(f32x4*)(rp + 4) = acc[ai][0][m][1]; }
            }
            return;
        }
        const int col0 = colt + wc * 32 + 8 * fq;
        if (colt < 2048) tile<1, false>(acc, row0, col0, fq); else if (colt < 4096) tile<1, true>(acc, row0, col0, fq); else if (colt < 5120) tile<2, false>(acc, row0, col0, fq);
        else if (colt < 8192) tile<0, false>(acc, row0, col0, fq); else tile<3, false>(acc, row0, col0, fq);
    }
};
struct EpiResidNorm {
    static constexpr bool PERM = true, AFTER_DRAIN = false;
    const float* r0; const float* r1; int split; float* out; bf16_t* hn; const float* gain; float* ssq;
    __device__ __forceinline__ void operator()(const f32x4 (&acc)[2][2][4][2], const Unit& u, int wr, int wc, int fr, int fq) const {
        const int row0 = u.pm * BM + wr * 64 + fr, col0 = u.pn * BM + wc * 32 + 8 * fq;
        const float* rb = (u.pm * BM < split) ? r0 : (r1 - (size_t)split * 4096);
        f32x4 gv[2][2];
#pragma unroll
        for (int bj = 0; bj < 2; ++bj)
#pragma unroll
            for (int n = 0; n < 2; ++n) gv[bj][n] = *(const f32x4*)(gain + col0 + bj * HALF + 4 * n);
#pragma unroll
        for (int ai = 0; ai < 2; ++ai)
#pragma unroll
            for (int m = 0; m < 4; ++m) { const int row = row0 + ai * HALF + m * 16; const size_t off = (size_t)row * 4096 + col0; float s = 0.f;
#pragma unroll
                for (int bj = 0; bj < 2; ++bj) { const f32x4 a0 = *(const f32x4*)(rb + off + bj * HALF) + acc[ai][bj][m][0], a1 = *(const f32x4*)(rb + off + bj * HALF + 4) + acc[ai][bj][m][1];
                    s += ((a0[0] * a0[0] + a0[1] * a0[1]) + (a0[2] * a0[2] + a0[3] * a0[3])) + ((a1[0] * a1[0] + a1[1] * a1[1]) + (a1[2] * a1[2] + a1[3] * a1[3]));
                    const f32x4 y0 = a0 * gv[bj][0], y1 = a1 * gv[bj][1]; u32x4 w; w.x = cvt_pk_bf16(y0[0], y0[1]); w.y = cvt_pk_bf16(y0[2], y0[3]); w.z = cvt_pk_bf16(y1[0], y1[1]); w.w = cvt_pk_bf16(y1[2], y1[3]);
                    *(u32x4*)(hn + off + bj * HALF) = w; }
                s += __shfl_xor(s, 16); s += __shfl_xor(s, 32);
                if (fq == 0) atomicAdd(ssq + row, s);
                asm volatile("" ::: "memory"); }
    }
};
struct EpiResidFinal {
    static constexpr bool PERM = true, AFTER_DRAIN = false;
    bf16_t* x2; const float* gain; float* ssq;
    __device__ __forceinline__ void operator()(const f32x4 (&acc)[2][2][4][2], const Unit& u, int wr, int wc, int fr, int fq) const {
        const int row0 = u.pm * BM + wr * 64 + fr, col0 = u.pn * BM + wc * 32 + 8 * fq;
        f32x4 rg[2][2];
#pragma unroll
        for (int bj = 0; bj < 2; ++bj)
#pragma unroll
            for (int n = 0; n < 2; ++n) { const f32x4 gvv = *(const f32x4*)(gain + col0 + bj * HALF + 4 * n); rg[bj][n][0] = 1.0f / gvv[0]; rg[bj][n][1] = 1.0f / gvv[1]; rg[bj][n][2] = 1.0f / gvv[2]; rg[bj][n][3] = 1.0f / gvv[3]; }
#pragma unroll
        for (int ai = 0; ai < 2; ++ai)
#pragma unroll
            for (int m = 0; m < 4; ++m) { const int row = row0 + ai * HALF + m * 16; const size_t off = (size_t)row * 4096 + col0; float s = 0.f;
#pragma unroll
                for (int bj = 0; bj < 2; ++bj) { const u32x4 hw = *(const u32x4*)(x2 + off + bj * HALF);
                    f32x4 v0, v1; v0[0] = __builtin_bit_cast(float, hw.x << 16); v0[1] = __builtin_bit_cast(float, hw.x & 0xffff0000u); v0[2] = __builtin_bit_cast(float, hw.y << 16); v0[3] = __builtin_bit_cast(float, hw.y & 0xffff0000u);
                    v1[0] = __builtin_bit_cast(float, hw.z << 16); v1[1] = __builtin_bit_cast(float, hw.z & 0xffff0000u); v1[2] = __builtin_bit_cast(float, hw.w << 16); v1[3] = __builtin_bit_cast(float, hw.w & 0xffff0000u);
                    v0 = v0 * rg[bj][0] + acc[ai][bj][m][0]; v1 = v1 * rg[bj][1] + acc[ai][bj][m][1];
                    s += ((v0[0] * v0[0] + v0[1] * v0[1]) + (v0[2] * v0[2] + v0[3] * v0[3])) + ((v1[0] * v1[0] + v1[1] * v1[1]) + (v1[2] * v1[2] + v1[3] * v1[3]));
                    u32x4 w; w.x = cvt_pk_bf16(v0[0], v0[1]); w.y = cvt_pk_bf16(v0[2], v0[3]); w.z = cvt_pk_bf16(v1[0], v1[1]); w.w = cvt_pk_bf16(v1[2], v1[3]); *(u32x4*)(x2 + off + bj * HALF) = w; }
                s += __shfl_xor(s, 16); s += __shfl_xor(s, 32);
                if (fq == 0) atomicAdd(ssq + row, s);
                asm volatile("" ::: "memory"); }
    }
};
struct EpiSwiglu {
    static constexpr bool PERM = true, AFTER_DRAIN = false;
    bf16_t* H; const float* ssq;
    __device__ __forceinline__ void operator()(const f32x4 (&acc)[2][2][4][2], const Unit& u, int wr, int wc, int fr, int fq) const {
        const int row0 = u.pm * BM + wr * 64 + fr, col0 = u.pn * HALF + wc * 32 + 8 * fq;
        float rsv[2][4];
#pragma unroll
        for (int ai = 0; ai < 2; ++ai)
#pragma unroll
            for (int m = 0; m < 4; ++m) rsv[ai][m] = ssq[row0 + ai * HALF + m * 16];
#pragma unroll
        for (int ai = 0; ai < 2; ++ai)
#pragma unroll
            for (int m = 0; m < 4; ++m) rsv[ai][m] = __builtin_amdgcn_rsqf(rsv[ai][m] * (1.f / 4096.f) + 1e-6f);
#pragma unroll
        for (int ai = 0; ai < 2; ++ai)
#pragma unroll
            for (int m = 0; m < 4; ++m) { const int row = row0 + ai * HALF + m * 16; const float rs = rsv[ai][m];
                const float rl = rs * -1.4426950408889634f, rq = rs * rs; u32x4 w;
                const f32x4 o0 = x_sigmoid_v(acc[ai][0][m][0] * acc[ai][1][m][0] * rq, acc[ai][0][m][0] * rl), o1 = x_sigmoid_v(acc[ai][0][m][1] * acc[ai][1][m][1] * rq, acc[ai][0][m][1] * rl);
                w.x = cvt_pk_bf16(o0[0], o0[1]); w.y = cvt_pk_bf16(o0[2], o0[3]); w.z = cvt_pk_bf16(o1[0], o1[1]); w.w = cvt_pk_bf16(o1[2], o1[3]);
                *(u32x4*)(H + (size_t)row * 11008 + col0) = w; }
    }
};

struct EpiPublish {
    static constexpr bool PERM = true, AFTER_DRAIN = false;
    float* slab; unsigned* flags; int nparts;
    __device__ __forceinline__ void operator()(const f32x4 (&acc)[2][2][4][2], const Unit& u, int wr, int wc, int fr, int fq) const {
        asm volatile("s_nop 15" ::: "memory");
        const int wid = wr * 4 + wc, lane = fq * 16 + fr;
        const __amdgpu_buffer_rsrc_t rs = __builtin_amdgcn_make_buffer_rsrc((void*)slab, (short)0, 0x7fffffff, 0x00020000);
        const unsigned off0 = ((unsigned)((u.tt * nparts + u.kp) * 8 + wid) * 16u * 64u + (unsigned)lane) * 16u;
#pragma unroll
        for (int ai = 0; ai < 2; ++ai)
#pragma unroll
            for (int bj = 0; bj < 2; ++bj)
#pragma unroll
                for (int m = 0; m < 4; ++m) { const int q = (ai * 2 + bj) * 4 + m; const f32x4 v0 = acc[ai][bj][m][0], v1 = acc[ai][bj][m][1]; u32x4 w;
                    w.x = cvt_pk_bf16(v0[0], v0[1]); w.y = cvt_pk_bf16(v0[2], v0[3]); w.z = cvt_pk_bf16(v1[0], v1[1]); w.w = cvt_pk_bf16(v1[2], v1[3]);
                    __builtin_amdgcn_raw_buffer_store_b128(w, rs, (int)(off0 + (unsigned)q * 1024u), 0, 16); }
        asm volatile("s_waitcnt vmcnt(0)" ::: "memory");
        if (lane == 0) __hip_atomic_fetch_add(flags + 16 * u.tt, 1u, __ATOMIC_RELAXED, __HIP_MEMORY_SCOPE_AGENT);
    }
};
struct EpiPublishNP : EpiPublish { static constexpr bool PERM = false; };
template <class Base> __device__ __forceinline__ void tail_combine(const TailOrder& TO, const Base& E, const float* slab, unsigned* flags, int nparts) {
    Unit u; if (!TO.next(0, u) || u.kp != 0) return;
    int tid_ = threadIdx.x; asm volatile("" : "+v"(tid_));
    const int wid = __builtin_amdgcn_readfirstlane(tid_ >> 6), lane = tid_ & 63, wr = wid >> 2, wc = wid & 3, fr = lane & 15, fq = lane >> 4;
    { unsigned* flag = flags + 16 * u.tt; const unsigned want = 8u * (unsigned)nparts; unsigned spins = 0;
      while ((unsigned)__builtin_amdgcn_readfirstlane(__hip_atomic_load(flag, __ATOMIC_RELAXED, __HIP_MEMORY_SCOPE_AGENT)) < want) { __builtin_amdgcn_s_sleep(2); if (++spins > (1u << 22)) break; }
      __builtin_amdgcn_fence(__ATOMIC_ACQUIRE, "agent"); asm volatile("s_waitcnt vmcnt(0)" ::: "memory"); }
    f32x4 acc[2][2][4][2];
#pragma unroll
    for (int ai = 0; ai < 2; ++ai)
#pragma unroll
        for (int bj = 0; bj < 2; ++bj)
#pragma unroll
            for (int m = 0; m < 4; ++m)
#pragma unroll
                for (int n = 0; n < 2; ++n) acc[ai][bj][m][n] = (f32x4){0.f, 0.f, 0.f, 0.f};
    for (int p = 0; p < nparts; ++p) {
        const u32x4* src = (const u32x4*)slab + ((size_t)((u.tt * nparts + p) * 8 + wid) * 16) * 64 + lane;
#pragma unroll
        for (int ai = 0; ai < 2; ++ai)
#pragma unroll
            for (int bj = 0; bj < 2; ++bj) {
#pragma unroll
                for (int m = 0; m < 4; ++m) { const int q = (ai * 2 + bj) * 4 + m; const u32x4 w = src[(size_t)q * 64]; f32x4 v0, v1;
                    v0[0] = __builtin_bit_cast(float, w.x << 16); v0[1] = __builtin_bit_cast(float, w.x & 0xffff0000u); v0[2] = __builtin_bit_cast(float, w.y << 16); v0[3] = __builtin_bit_cast(float, w.y & 0xffff0000u);
                    v1[0] = __builtin_bit_cast(float, w.z << 16); v1[1] = __builtin_bit_cast(float, w.z & 0xffff0000u); v1[2] = __builtin_bit_cast(float, w.w << 16); v1[3] = __builtin_bit_cast(float, w.w & 0xffff0000u);
                    acc[ai][bj][m][0] += v0; acc[ai][bj][m][1] += v1; }
                asm volatile("" ::: "memory"); }
    }
    E(acc, u, wr, wc, fr, fq);
}
template <class Epi, class Sched, bool ALIGN_EPI = false, bool SP2 = false>
__device__ __forceinline__ void gemm_phase(PG8_LAS unsigned char* lds, const Gemm g, const Sched& S, const Epi& E) {
    int tid_ = threadIdx.x; asm volatile("" : "+v"(tid_));
    const int tid = tid_, wid = __builtin_amdgcn_readfirstlane(tid >> 6), lane = tid & 63, wr = wid >> 2, wc = wid & 3, fr = lane & 15, fq = lane >> 4;
    const int K = g.K, nt = K / BK, LD = g.ld ? g.ld : g.K;
    unsigned voffA[2], voffB[2];
#pragma unroll
    for (int i = 0; i < 2; ++i) { int R, C; stage_rc(tid * 16 + i * 8192, R, C); const int Rb = Epi::PERM ? ((R & ~31) + perm32(R & 31)) : R;
        voffA[i] = (unsigned)(R * LD + C) * 2u; voffB[i] = (unsigned)(Rb * LD + C) * 2u; }
    const size_t kstep = (size_t)(BK * 2);
    const size_t hstep = (size_t)HALF * LD * 2;
    const size_t tstep = 2 * hstep;
    const unsigned ldsw = (unsigned)wid * 1024u;
    const int aoff = lds_byte(wr * 64 + fr, fq * 8), boff = lds_byte(wc * 32 + fr, fq * 8);
#define PG8_SA(b, h) (((b) * 2 + (h)) * HTB)
#define PG8_SB(b, h) ((4 + (b) * 2 + (h)) * HTB)
#define PG8_STAGE(bufoff, gbase, voff) do { _Pragma("unroll") for (int _i = 0; _i < 2; ++_i) \
        __builtin_amdgcn_global_load_lds((const unsigned*)((const char*)(gbase) + (voff)[_i]), (PG8_LAS unsigned*)(lds + (bufoff) + ldsw + _i * 8192), 16, 0, 0); } while (0)
#define PG8_LDA(dst, b, h) do { _Pragma("unroll") for (int m = 0; m < 4; ++m) _Pragma("unroll") for (int k = 0; k < 2; ++k) dst[m][k] = *(const PG8_LAS bf16x8*)(lds + PG8_SA(b, h) + aoff + m * 2048 + k * 1024); } while (0)
#define PG8_LDB(dst, b, h) do { _Pragma("unroll") for (int n = 0; n < 2; ++n) _Pragma("unroll") for (int k = 0; k < 2; ++k) dst[n][k] = *(const PG8_LAS bf16x8*)(lds + PG8_SB(b, h) + boff + n * 2048 + k * 1024); } while (0)
#define PG8_MMA(ai, bj, At, Bt) do { __builtin_amdgcn_s_setprio(1); _Pragma("unroll") for (int m = 0; m < 4; ++m) _Pragma("unroll") for (int n = 0; n < 2; ++n) _Pragma("unroll") for (int k = 0; k < 2; ++k) \
        acc[ai][bj][m][n] = __builtin_amdgcn_mfma_f32_16x16x32_bf16(Bt[n][k], At[m][k], acc[ai][bj][m][n], 0, 0, 0); __builtin_amdgcn_s_setprio(0); } while (0)
#define PG8_WAIT_V(n) asm volatile("s_waitcnt vmcnt(" #n ")" ::: "memory")
#define PG8_WAIT_L(n) asm volatile("s_waitcnt lgkmcnt(" #n ")" ::: "memory")
#define PG8_BAR __builtin_amdgcn_s_barrier()
#define PG8_SCHED __builtin_amdgcn_sched_barrier(0)
    Unit cur, nxt; int ui = 0;
    if (!S.next(0, cur)) return;
    f32x4 acc[2][2][4][2];
#pragma unroll
    for (int a = 0; a < 2; ++a)
#pragma unroll
        for (int b = 0; b < 2; ++b)
#pragma unroll
            for (int m = 0; m < 4; ++m)
#pragma unroll
                for (int n = 0; n < 2; ++n) acc[a][b][m][n] = (f32x4){0.f, 0.f, 0.f, 0.f};
    bf16x8 At[4][2], B0[2][2], B1[2][2];
    const char* cA = (const char*)g.A + (size_t)cur.pm * tstep + (size_t)cur.kp * K * 2; const char* cB = (const char*)g.Bt + (size_t)cur.pn * tstep + (size_t)cur.kp * K * 2;
    S.a_ready(cur);
    if constexpr (SP2) {
        PG8_STAGE(PG8_SB(0, 0), cB, voffB); PG8_STAGE(PG8_SB(0, 1), cB + hstep, voffB); PG8_STAGE(PG8_SA(0, 0), cA, voffA); PG8_STAGE(PG8_SA(0, 1), cA + hstep, voffA);
        if (wr == 1) PG8_BAR;
        PG8_WAIT_V(2); PG8_BAR;
        PG8_STAGE(PG8_SB(1, 0), cB + kstep, voffB); PG8_STAGE(PG8_SA(1, 0), cA + kstep, voffA); PG8_STAGE(PG8_SB(1, 1), cB + hstep + kstep, voffB);
        PG8_WAIT_V(6); PG8_BAR;
    } else {
        PG8_STAGE(PG8_SB(0, 0), cB, voffB); PG8_STAGE(PG8_SA(0, 0), cA, voffA); PG8_STAGE(PG8_SB(0, 1), cB + hstep, voffB); PG8_STAGE(PG8_SA(0, 1), cA + hstep, voffA);
        if (wr == 1) PG8_BAR;
        PG8_WAIT_V(4); PG8_BAR;
        PG8_STAGE(PG8_SB(1, 0), cB + kstep, voffB); PG8_STAGE(PG8_SA(1, 0), cA + kstep, voffA); PG8_STAGE(PG8_SB(1, 1), cB + hstep + kstep, voffB);
        PG8_WAIT_V(6); PG8_BAR;
    }
    for (;;) {
        const bool has_next = S.next(ui + 1, nxt);
        const char* nA = has_next ? (const char*)g.A + (size_t)nxt.pm * tstep + (size_t)nxt.kp * K * 2 : cA; const char* nB = has_next ? (const char*)g.Bt + (size_t)nxt.pn * tstep + (size_t)nxt.kp * K * 2 : cB;
        for (int t = 0; t < nt; t += 2) {
            const bool last = (t == nt - 2);
            const char* a1 = cA + (size_t)(t + 1) * kstep;
            const char* a2 = last ? nA : cA + (size_t)(t + 2) * kstep; const char* b2 = last ? nB : cB + (size_t)(t + 2) * kstep;
            const char* a3 = a2 + kstep; const char* b3 = b2 + kstep;
            if (last && has_next) S.a_ready(nxt);
            if constexpr (SP2) {
            PG8_LDB(B0, 0, 0); PG8_LDB(B1, 0, 1); PG8_SCHED; PG8_LDA(At, 0, 0); PG8_STAGE(PG8_SA(1, 1), a1 + hstep, voffA);
            PG8_WAIT_V(8); PG8_WAIT_L(0); PG8_BAR; PG8_MMA(0, 0, At, B0); PG8_MMA(0, 1, At, B1); PG8_BAR; PG8_SCHED;
            PG8_LDA(At, 0, 1); PG8_STAGE(PG8_SB(0, 0), b2, voffB); PG8_STAGE(PG8_SB(0, 1), b2 + hstep, voffB); PG8_STAGE(PG8_SA(0, 0), a2, voffA);
            PG8_WAIT_V(8); PG8_WAIT_L(0); PG8_BAR; PG8_MMA(1, 0, At, B0); PG8_MMA(1, 1, At, B1); PG8_BAR; PG8_SCHED;
            PG8_LDB(B0, 1, 0); PG8_LDB(B1, 1, 1); PG8_SCHED; PG8_LDA(At, 1, 0); PG8_STAGE(PG8_SA(0, 1), a2 + hstep, voffA);
            PG8_WAIT_V(8); PG8_WAIT_L(0); PG8_BAR; PG8_MMA(0, 0, At, B0); PG8_MMA(0, 1, At, B1); PG8_BAR; PG8_SCHED;
            PG8_LDA(At, 1, 1); PG8_STAGE(PG8_SB(1, 0), b3, voffB); PG8_STAGE(PG8_SB(1, 1), b3 + hstep, voffB); PG8_STAGE(PG8_SA(1, 0), a3, voffA);
            PG8_WAIT_V(8); PG8_WAIT_L(0); PG8_BAR; PG8_MMA(1, 0, At, B0); PG8_MMA(1, 1, At, B1); PG8_BAR; PG8_SCHED;
            } else {
            PG8_LDB(B0, 0, 0); PG8_SCHED; PG8_LDA(At, 0, 0); PG8_STAGE(PG8_SA(1, 1), a1 + hstep, voffA);
            PG8_WAIT_L(8); PG8_BAR; PG8_WAIT_L(0); PG8_MMA(0, 0, At, B0); PG8_BAR; PG8_SCHED;
            PG8_LDB(B1, 0, 1); PG8_STAGE(PG8_SB(0, 0), b2, voffB);
            PG8_BAR; PG8_WAIT_L(0); PG8_MMA(0, 1, At, B1); PG8_BAR;
            PG8_LDA(At, 0, 1); PG8_STAGE(PG8_SA(0, 0), a2, voffA);
            PG8_BAR; PG8_WAIT_L(0); PG8_MMA(1, 0, At, B0); PG8_BAR; PG8_SCHED;
            PG8_STAGE(PG8_SB(0, 1), b2 + hstep, voffB);
            PG8_WAIT_V(6); PG8_BAR; PG8_MMA(1, 1, At, B1); PG8_BAR;
            PG8_LDB(B0, 1, 0); PG8_SCHED; PG8_LDA(At, 1, 0); PG8_STAGE(PG8_SA(0, 1), a2 + hstep, voffA);
            PG8_WAIT_L(8); PG8_BAR; PG8_WAIT_L(0); PG8_MMA(0, 0, At, B0); PG8_BAR; PG8_SCHED;
            PG8_LDB(B1, 1, 1); PG8_STAGE(PG8_SB(1, 0), b3, voffB);
            PG8_BAR; PG8_WAIT_L(0); PG8_MMA(0, 1, At, B1); PG8_BAR;
            PG8_LDA(At, 1, 1); PG8_STAGE(PG8_SA(1, 0), a3, voffA);
            PG8_BAR; PG8_WAIT_L(0); PG8_MMA(1, 0, At, B0); PG8_BAR; PG8_SCHED;
            PG8_STAGE(PG8_SB(1, 1), b3 + hstep, voffB);
            PG8_WAIT_V(6); PG8_BAR; PG8_MMA(1, 1, At, B1); PG8_BAR;
            }
        }
        if constexpr (ALIGN_EPI) { if (wr == 0) PG8_BAR; }
        if constexpr (!Epi::AFTER_DRAIN) { E(acc, cur, wr, wc, fr, fq); S.done(cur); }
        if (!has_next) break;
#pragma unroll
        for (int a = 0; a < 2; ++a)
#pragma unroll
            for (int b = 0; b < 2; ++b)
#pragma unroll
                for (int m = 0; m < 4; ++m)
#pragma unroll
                    for (int n = 0; n < 2; ++n) acc[a][b][m][n] = (f32x4){0.f, 0.f, 0.f, 0.f};
        cur = nxt; cA = nA; cB = nB; ++ui;
        if constexpr (ALIGN_EPI) { if (wr == 1) PG8_BAR; }
    }
    PG8_WAIT_V(0);
    if constexpr (!ALIGN_EPI) { if (wr == 0) PG8_BAR; }
    PG8_BAR;
    if constexpr (Epi::AFTER_DRAIN) { E.fused(acc, cur, wr, wc, fr, fq, lds, wid, lane); S.done(cur); }
#undef PG8_SA
#undef PG8_SB
#undef PG8_STAGE
#undef PG8_LDA
#undef PG8_LDB
#undef PG8_MMA
#undef PG8_WAIT_V
#undef PG8_WAIT_L
#undef PG8_BAR
#undef PG8_SCHED
}
}

constexpr int NWAVES = 8;
constexpr int DM = 4096, MP = 16384, MS = 2048, M = MP + MS;
constexpr int AWID = 2048, AHD = 128, HK = 256, HV = 512, NHB = 4, DFF = 11008;
constexpr int INC = 10256, NPROJ = 10240, NPAD = 10496;
constexpr int C_U = 0, C_V = 2048, C_Q = 4096, C_K = 5120, C_VV = 6144, C_R = 8192;
constexpr int NBLK = M / 64, NBH = NBLK * NHB;
constexpr int NG = 8, GB = 32;
constexpr float EPS = 1e-6f;
constexpr size_t O_Y = 0, O_GP = (size_t)M * DM, O_GS = O_GP + (size_t)NHB * HK * HV, O_SV = O_GS + (size_t)32 * NHB * HK * HV, O_END = O_SV + (size_t)MS * AWID;
static_assert(O_END == 96993280, "output size");

constexpr size_t WS_CTL = 0, CTL_ZERO_BYTES = 1u << 20;
constexpr size_t WS_WIN = CTL_ZERO_BYTES;
constexpr size_t WS_WOUT = WS_WIN + (size_t)NPAD * DM * 2;
constexpr size_t WS_WGU = WS_WOUT + (size_t)DM * DM * 2;
constexpr size_t WS_WDN = WS_WGU + (size_t)2 * DFF * DM * 2;
constexpr size_t WS_HN = WS_WDN + (size_t)DM * DFF * 2;
constexpr size_t WS_PROJ = WS_HN + (size_t)M * DM * 2;
constexpr size_t WS_MIX = WS_PROJ + (size_t)M * NPROJ * 2;
constexpr size_t WS_QE = WS_MIX + (size_t)M * DM * 2;
constexpr size_t WS_GLR = WS_QE + (size_t)M * 1024 * 2;
constexpr size_t WS_STATS = WS_GLR + (size_t)M * 16 * 4;
constexpr size_t WS_BLAST = WS_STATS + (size_t)M * 2 * 4;
constexpr size_t WS_LST = WS_BLAST + (size_t)NBH * HK * 4;
constexpr size_t WS_GDEC = WS_LST + (size_t)NG * NHB * HK * HV * 4;
constexpr size_t WS_END = WS_GDEC + (size_t)NG * NHB * HK * 4;
constexpr size_t WS_KLT = WS_HN;
constexpr size_t WS_ATT = WS_KLT + (size_t)NBH * HK * 64 * 2;
constexpr size_t WS_VT = WS_ATT + (size_t)NBH * 64 * 64 * 2;
static_assert(WS_VT + (size_t)NBH * HV * 64 * 2 <= WS_PROJ, "GLA block operands overlay HN");
constexpr size_t WS_O = WS_WIN;
static_assert((size_t)M * 2048 * 2 <= (size_t)NPAD * DM * 2, "O overlays WIN");
constexpr size_t WS_SLAB = WS_WIN;
static_assert((size_t)144 * 262144 <= (size_t)NPAD * DM * 2, "slabs overlay WIN");
constexpr size_t WS_HFF = WS_PROJ;
static_assert(WS_HFF + (size_t)M * DFF * 2 <= WS_QE, "HFF overlays PROJ|MIX");
static_assert(WS_END <= 1146501120ull, "workspace budget = sum of the inputs");
constexpr int CW_BAR = 4096;
constexpr int CW_SSQ = 32768;
constexpr int CW_SSQ2 = 65536;
constexpr int CW_VST = 131072;
constexpr int CW_FLAG = 98304;
constexpr int CW_XRANK = 12288;

constexpr int RING_BYTES = 131072, PHASE_LDS = 139264, MISC_OFF = PHASE_LDS + 320, LDS_BYTES = 147456;

#define GAS __attribute__((address_space(1)))
#define LAS __attribute__((address_space(3)))
typedef unsigned short bf16;
typedef unsigned v4u __attribute__((ext_vector_type(4)));
typedef unsigned v2u __attribute__((ext_vector_type(2)));
typedef float f32x4 __attribute__((ext_vector_type(4)));
typedef short bf16x8 __attribute__((ext_vector_type(8)));
#define LDS_WAIT() asm volatile("s_waitcnt lgkmcnt(0)" ::: "memory")
#define LDS_BARRIER() asm volatile("s_waitcnt lgkmcnt(0)\n\ts_barrier" ::: "memory")
#define MFMA16(a, b, c) __builtin_amdgcn_mfma_f32_16x16x32_bf16((a), (b), (c), 0, 0, 0)
__device__ __forceinline__ unsigned f2bf(float f) { unsigned u = __builtin_bit_cast(unsigned, f); return (u + 0x7fffu + ((u >> 16) & 1u)) >> 16; }
__device__ __forceinline__ unsigned pk2(float lo, float hi) { return f2bf(lo) | (f2bf(hi) << 16); }
__device__ __forceinline__ unsigned pk2hw(float lo, float hi) { unsigned r; asm("v_cvt_pk_bf16_f32 %0, %1, %2" : "=v"(r) : "v"(lo), "v"(hi)); return r; }
__device__ __forceinline__ float bflo(unsigned w) { return __builtin_bit_cast(float, w << 16); }
__device__ __forceinline__ float bfhi(unsigned w) { return __builtin_bit_cast(float, w & 0xffff0000u); }
__device__ __forceinline__ float bf2f(bf16 b) { return __builtin_bit_cast(float, (unsigned)b << 16); }

#define XB_TMO      128
#define XB_XCNT(j)  (256  + 64 * (j))
#define XB_XSUB(j)  (1280 + 64 * (j))
#define XB_XGEN(j)  (2304 + 64 * (j))
#define XB_TOP      3328
#define XB_TOPGEN   3392
#define XCD_BAR_WORDS 3456
#define XB_SPIN_CAP (1u << 18)

__device__ __forceinline__ unsigned xb_ld(unsigned* p)              { return __hip_atomic_load(p, __ATOMIC_RELAXED, __HIP_MEMORY_SCOPE_AGENT); }
__device__ __forceinline__ unsigned xb_add(unsigned* p, unsigned v) { return __hip_atomic_fetch_add(p, v, __ATOMIC_RELAXED, __HIP_MEMORY_SCOPE_AGENT); }
__device__ __forceinline__ unsigned xb_xcc_id() { return (unsigned)__builtin_amdgcn_s_getreg((3 << 11) | 20) & 0xFu; }
#define XB_SPIN(cond, bar) do { unsigned _sp = 0; while (cond) { __builtin_amdgcn_s_sleep(1); \
    if ((++_sp & 255u) == 0u) { if (xb_ld(&(bar)[XB_TMO])) break; if (_sp > XB_SPIN_CAP) { atomicAdd(&(bar)[XB_TMO], 1u); break; } } } } while (0)

struct XcdBarrier {
    unsigned* bar; unsigned x;
    volatile LAS unsigned* st;
};

__device__ __forceinline__ XcdBarrier xcd_barrier_post(unsigned* bar, volatile LAS unsigned* st) {
    XcdBarrier b; b.bar = bar; b.x = xb_xcc_id(); b.st = st;
    if (threadIdx.x == 0) (void)xb_add(&bar[XB_XCNT(b.x)], 1u);
    return b;
}
__device__ __forceinline__ void xcd_barrier_complete(unsigned* bar, unsigned x, unsigned& nloc, unsigned& nx) {
    const unsigned G = gridDim.x * gridDim.y * gridDim.z;
    unsigned sum, cnt, mine, sp = 0u;
    for (;;) {
        sum = 0u; cnt = 0u; mine = 0u;
#pragma unroll
        for (unsigned j = 0; j < 16; ++j) { const unsigned c = xb_ld(&bar[XB_XCNT(j)]); sum += c; cnt += (c > 0u) ? 1u : 0u; mine = (j == x) ? c : mine; }
        if (sum == G) break;
        __builtin_amdgcn_s_sleep(1);
        if ((++sp & 255u) == 0u) { if (xb_ld(&bar[XB_TMO])) break; if (sp > XB_SPIN_CAP) { atomicAdd(&bar[XB_TMO], 1u); break; } }
    }
    nloc = mine > 0u ? mine : 1u; nx = cnt > 0u ? cnt : 1u;
}

__device__ __forceinline__ void xcd_barrier(const XcdBarrier& b) {
    asm volatile("s_waitcnt vmcnt(0)" ::: "memory");
    __syncthreads();
    if (threadIdx.x == 0) {
        unsigned* bar = b.bar;
        __builtin_amdgcn_s_waitcnt(0);
        unsigned nloc = b.st[0], nx = b.st[1];
        if (nloc == 0u) { xcd_barrier_complete(bar, b.x, nloc, nx); b.st[0] = nloc; b.st[1] = nx; }
        const unsigned old = xb_add(&bar[XB_XSUB(b.x)], 1u);
        const unsigned gen = old / nloc;
        if (old + 1u == (gen + 1u) * nloc) {
            __builtin_amdgcn_fence(__ATOMIC_RELEASE, "agent");
            asm volatile("s_waitcnt vmcnt(0)" ::: "memory");
            const unsigned og = xb_add(&bar[XB_TOP], 1u);
            const unsigned tg = og / nx;
            if (og + 1u == (tg + 1u) * nx) xb_add(&bar[XB_TOPGEN], 1u);
            else XB_SPIN(xb_ld(&bar[XB_TOPGEN]) == tg, bar);
            __builtin_amdgcn_fence(__ATOMIC_ACQUIRE, "agent");
            xb_add(&bar[XB_XGEN(b.x)], 1u);
            asm volatile("s_waitcnt vmcnt(0)" ::: "memory");
        } else {
            XB_SPIN(xb_ld(&bar[XB_XGEN(b.x)]) == gen, bar);
            __builtin_amdgcn_fence(__ATOMIC_ACQUIRE, "agent");
            asm volatile("s_waitcnt vmcnt(0)" ::: "memory");
        }
    }
    __syncthreads();
}
struct Frame {
    LAS unsigned char* lds;
    unsigned* ctl;
    int tid, lane, wave, G, wg, wgv;
    const float *x_prompt, *x_sample, *state_gla, *g_mix, *w_in, *w_s, *b_s, *ln_g, *ln_b, *w_gate_up, *b_gate, *gla_norm_g, *w_out, *g_ffn, *w_ffn_gate, *w_ffn_up, *w_ffn_down, *g_final;
    float* out;
    bf16 *WIN, *WOUT, *WGU, *WDN, *HN, *PROJ, *MIX, *QE, *KLT, *ATT, *VT, *O, *HFF;
    float *GLR, *STATS, *BLAST, *LST, *GDEC;
};
__device__ __forceinline__ const float* x_row(const Frame& F, int m) { return m < MP ? F.x_prompt + (size_t)m * DM : F.x_sample + (size_t)(m - MP) * DM; }
__device__ __forceinline__ float wave_sum(float v) {
#pragma unroll
    for (int o = 1; o < 64; o <<= 1) v += __shfl_xor(v, o);
    return v;
}

__device__ __forceinline__ void transpose_item(const float* W, int ldw, int K, int k0, int n0, int nvalid, bf16* WTrow0, LAS float* scr, int lane) {
    const float* src = W + (size_t)k0 * ldw + n0 + lane; const bool ok = lane < nvalid;
    float v[64];
#pragma unroll
    for (int kk = 0; kk < 64; ++kk) v[kk] = ok ? src[(size_t)kk * ldw] : 0.f;
#pragma unroll
    for (int kk = 0; kk < 64; ++kk) scr[kk * 65 + lane] = v[kk];
    LDS_WAIT(); asm volatile("" ::: "memory");
    const int c8 = lane & 7;
#pragma unroll
    for (int j = 0; j < 8; ++j) { const int n = (lane >> 3) + 8 * j; const LAS float* s = scr + (8 * c8) * 65 + n;
        v4u o; o.x = pk2hw(s[0 * 65], s[1 * 65]); o.y = pk2hw(s[2 * 65], s[3 * 65]); o.z = pk2hw(s[4 * 65], s[5 * 65]); o.w = pk2hw(s[6 * 65], s[7 * 65]);
        if (n < nvalid || nvalid >= 32) *(GAS v4u*)(WTrow0 + (size_t)n * K + k0 + 8 * c8) = o; }
    LDS_WAIT(); asm volatile("" ::: "memory");
}
struct RowGain { f32x4 g0[8], g1[8]; };
__device__ __forceinline__ void row_gain_load(const float* gain, int lane, RowGain& G) {
    const GAS f32x4* gr = (const GAS f32x4*)gain + 2 * lane;
#pragma unroll
    for (int j = 0; j < 8; ++j) { G.g0[j] = gr[128 * j]; G.g1[j] = gr[128 * j + 1]; }
}
__device__ __forceinline__ void rms_row_to_bf16(const float* xrow, const RowGain& G, bf16* orow, int lane) {
    const GAS f32x4* xr = (const GAS f32x4*)xrow + 2 * lane;
    f32x4 v[8][2]; float s = 0.f;
#pragma unroll
    for (int j = 0; j < 8; ++j) { v[j][0] = xr[128 * j]; v[j][1] = xr[128 * j + 1];
        s += ((v[j][0].x * v[j][0].x + v[j][0].y * v[j][0].y) + (v[j][0].z * v[j][0].z + v[j][0].w * v[j][0].w)) + ((v[j][1].x * v[j][1].x + v[j][1].y * v[j][1].y) + (v[j][1].z * v[j][1].z + v[j][1].w * v[j][1].w)); }
    const float rstd = 1.0f / sqrtf(wave_sum(s) * (1.f / DM) + EPS);
    GAS v4u* o16 = (GAS v4u*)orow + lane;
#pragma unroll
    for (int j = 0; j < 8; ++j) { const f32x4 g0 = G.g0[j], g1 = G.g1[j]; v4u w;
        w.x = pk2hw(v[j][0].x * rstd * g0.x, v[j][0].y * rstd * g0.y); w.y = pk2hw(v[j][0].z * rstd * g0.z, v[j][0].w * rstd * g0.w);
        w.z = pk2hw(v[j][1].x * rstd * g1.x, v[j][1].y * rstd * g1.y); w.w = pk2hw(v[j][1].z * rstd * g1.z, v[j][1].w * rstd * g1.w); o16[64 * j] = w; }
}
constexpr int P0_NB_IN = (INC + 63) / 64;
constexpr int P0_I_IN = 64 * P0_NB_IN, P0_I_OUT = 64 * 64, P0_I_G = 64 * (DFF / 64), P0_I_D = (DFF / 64) * 64, P0_NITEMS = P0_I_IN + P0_I_OUT + 2 * P0_I_G + P0_I_D;
#ifndef P0_MOVED
#define P0_MOVED 1536
#endif
__device__ __forceinline__ void convert_items(Frame& F, int it0, int it1, int gw, int nw) {
    int lane_ = F.lane, wave_ = F.wave; asm volatile("" : "+v"(lane_), "+s"(wave_));
    LAS float* scr = (LAS float*)(F.lds + wave_ * 16640);
    for (int it = it0 + gw; it < it1; it += nw) {
        int r = it;
        if (r < P0_I_OUT) { const int kb = r / 64, nb = r % 64, n0 = 64 * nb; transpose_item(F.w_out, DM, DM, 64 * kb, n0, 64, F.WOUT + (size_t)n0 * DM, scr, lane_); continue; } r -= P0_I_OUT;
        if (r < 2 * P0_I_G) { const int up = r >= P0_I_G; if (up) r -= P0_I_G; const int nbn = DFF / 64, kb = r / nbn, nb = r % nbn, n0 = 64 * nb;
            const int row0 = (n0 / 128) * 256 + up * 128 + (n0 % 128);
            transpose_item(up ? F.w_ffn_up : F.w_ffn_gate, DFF, DM, 64 * kb, n0, 64, F.WGU + (size_t)row0 * DM, scr, lane_); continue; } r -= 2 * P0_I_G;
        if (r < P0_I_D) { const int kb = r / 64, nb = r % 64, n0 = 64 * nb; transpose_item(F.w_ffn_down, DM, DFF, 64 * kb, n0, 64, F.WDN + (size_t)n0 * DFF, scr, lane_); continue; } r -= P0_I_D;
        { const int kb = r / P0_NB_IN, nb = r % P0_NB_IN, n0 = 64 * nb; transpose_item(F.w_in, INC, DM, 64 * kb, n0, INC - n0 >= 64 ? 64 : INC - n0, F.WIN + (size_t)n0 * DM, scr, lane_); }
    }
}
struct CvtItem { const float* src; bf16* dst; int ldw, K, k0; };
__device__ __forceinline__ CvtItem cvt_decode(const Frame& F, int it) {
    int r = it - P0_I_OUT; CvtItem c;
    if (r < 2 * P0_I_G) { const int up = r >= P0_I_G; if (up) r -= P0_I_G; const int nbn = DFF / 64, kb = r / nbn, nb = r % nbn, n0 = 64 * nb, row0 = (n0 / 128) * 256 + up * 128 + (n0 % 128);
        c.src = (up ? F.w_ffn_up : F.w_ffn_gate) + (size_t)(64 * kb) * DFF + n0; c.dst = F.WGU + (size_t)row0 * DM; c.ldw = DFF; c.K = DM; c.k0 = 64 * kb; return c; }
    r -= 2 * P0_I_G; { const int kb = r / 64, nb = r % 64, n0 = 64 * nb; c.src = F.w_ffn_down + (size_t)(64 * kb) * DM + n0; c.dst = F.WDN + (size_t)n0 * DFF; c.ldw = DM; c.K = DFF; c.k0 = 64 * kb; return c; }
}
__device__ __forceinline__ void cvt_load(const CvtItem& c, int lane, float (&v)[64]) {
    const float* s = c.src + lane;
#pragma unroll
    for (int kk = 0; kk < 64; ++kk) v[kk] = s[(size_t)kk * c.ldw];
}
__device__ __forceinline__ void cvt_store(const CvtItem& c, int lane, const float (&v)[64], LAS float* scr) {
#pragma unroll
    for (int kk = 0; kk < 64; ++kk) scr[kk * 65 + lane] = v[kk];
    LDS_WAIT(); asm volatile("" ::: "memory");
    const int c8 = lane & 7;
#pragma unroll
    for (int j = 0; j < 8; ++j) { const int n = (lane >> 3) + 8 * j; const LAS float* s = scr + (8 * c8) * 65 + n;
        v4u o; o.x = pk2hw(s[0 * 65], s[1 * 65]); o.y = pk2hw(s[2 * 65], s[3 * 65]); o.z = pk2hw(s[4 * 65], s[5 * 65]); o.w = pk2hw(s[6 * 65], s[7 * 65]);
        *(GAS v4u*)(c.dst + (size_t)n * c.K + c.k0 + 8 * c8) = o; }
    LDS_WAIT(); asm volatile("" ::: "memory");
}
__device__ __forceinline__ void convert_items_pipelined(Frame& F, int it0, int it1, int gw, int nw) {
    int lane_ = F.lane, wave_ = F.wave; asm volatile("" : "+v"(lane_), "+s"(wave_));
    LAS float* scr = (LAS float*)(F.lds + wave_ * 16640);
    int it = it0 + gw; if (it >= it1) return;
    float va[64], vb[64]; CvtItem ca = cvt_decode(F, it), cb = ca; cvt_load(ca, lane_, va);
    for (;;) {
        const int i1 = it + nw; const bool h1 = i1 < it1; if (h1) { cb = cvt_decode(F, i1); cvt_load(cb, lane_, vb); }
        cvt_store(ca, lane_, va, scr);
        if (!h1) break;
        const int i2 = i1 + nw; const bool h2 = i2 < it1; if (h2) { ca = cvt_decode(F, i2); cvt_load(ca, lane_, va); }
        cvt_store(cb, lane_, vb, scr);
        if (!h2) break;
        it = i2;
    }
}
#ifndef P1_DED
#define P1_DED 12288
#endif
__device__ __forceinline__ void p0_prologue(Frame& F) {
    const int gw = F.wg * NWAVES + F.wave, NGW = F.G * NWAVES;
    constexpr int FFN_END = P0_I_OUT + 2 * P0_I_G + P0_I_D;
#pragma unroll
    for (int rp = 0; rp < 1; ++rp) { convert_items(F, 0, FFN_END - P0_MOVED - (F.G == 256 ? P1_DED : 0), gw, NGW); convert_items(F, FFN_END, P0_NITEMS, gw, NGW); }
#pragma unroll
    for (int rp = 0; rp < 1; ++rp) { RowGain RG; row_gain_load(F.g_mix, F.lane, RG); for (int m = gw; m < M; m += NGW) rms_row_to_bf16(x_row(F, m), RG, F.HN + (size_t)m * DM, F.lane); }
}

__device__ __forceinline__ void ln_mean_rstd(const Frame& F, int m, float& mean, float& rstd) {
    const float s1 = ((const float*)(F.ctl + CW_VST))[2 * m], s2 = ((const float*)(F.ctl + CW_VST))[2 * m + 1];
    mean = s1 * (1.f / AWID); rstd = 1.0f / sqrtf(fmaxf(s2 * (1.f / AWID) - mean * mean, 0.f) + EPS);
}
__device__ __forceinline__ void ln_sample_row(Frame& F, int m) {
    const GAS v4u* vr = (const GAS v4u*)(F.PROJ + (size_t)m * NPROJ + C_V) + F.lane;
    float mean, rstd; ln_mean_rstd(F, m, mean, rstd);
    float* o = F.out + O_SV + (size_t)(m - MP) * AWID;
#pragma unroll
    for (int i = 0; i < 4; ++i) { const v4u w = vr[64 * i]; const int c = 8 * (F.lane + 64 * i);
        const float f[8] = {bflo(w.x), bfhi(w.x), bflo(w.y), bfhi(w.y), bflo(w.z), bfhi(w.z), bflo(w.w), bfhi(w.w)};
        const f32x4 g0 = *(const f32x4*)(F.ln_g + c), g1 = *(const f32x4*)(F.ln_g + c + 4), b0 = *(const f32x4*)(F.ln_b + c), b1 = *(const f32x4*)(F.ln_b + c + 4);
        f32x4 o0, o1;
        o0.x = (f[0] - mean) * rstd * g0.x + b0.x; o0.y = (f[1] - mean) * rstd * g0.y + b0.y; o0.z = (f[2] - mean) * rstd * g0.z + b0.z; o0.w = (f[3] - mean) * rstd * g0.w + b0.w;
        o1.x = (f[4] - mean) * rstd * g1.x + b1.x; o1.y = (f[5] - mean) * rstd * g1.y + b1.y; o1.z = (f[6] - mean) * rstd * g1.z + b1.z; o1.w = (f[7] - mean) * rstd * g1.w + b1.w;
        *(f32x4*)(o + c) = o0; *(f32x4*)(o + c + 4) = o1; }
}
__device__ __forceinline__ float log_sigmoid_f(float z) { return fminf(z, 0.f) - __logf(1.0f + __expf(-fabsf(z))); }
constexpr int PREP_GLR = 0, PREP_TOT = 4096, PREP_BREF = 5120, PREP_BLAST = 6144, PREP_QD = 8192, PREP_PITCH = 264, PREP_KD = PREP_QD + 64 * PREP_PITCH * 2, PREP_END = PREP_KD + 64 * PREP_PITCH * 2;
static_assert(PREP_END <= RING_BYTES, "prep LDS");
__device__ __forceinline__ void gla_prep_unit(Frame& F, int bh) {
    const int blk = bh >> 2, h = bh & 3, m0 = 64 * blk, kd = F.tid & 255, half = F.tid >> 8;
    LAS float* glr_l = (LAS float*)(F.lds + PREP_GLR); LAS float* tot = (LAS float*)(F.lds + PREP_TOT); LAS float* bref = (LAS float*)(F.lds + PREP_BREF); LAS float* blast = (LAS float*)(F.lds + PREP_BLAST);
    LAS bf16* QD = (LAS bf16*)(F.lds + PREP_QD); LAS bf16* KD = (LAS bf16*)(F.lds + PREP_KD);
    v4u qraw[4], kraw[4];
#pragma unroll
    for (int r = 0; r < 4; ++r) { const int q = F.tid + 512 * r, row = q >> 5, c = q & 31; const bf16* src = F.PROJ + (size_t)(m0 + row) * NPROJ + C_Q + h * HK + 8 * c;
        qraw[r] = *(const GAS v4u*)src; kraw[r] = *(const GAS v4u*)(src + (C_K - C_Q)); }
    for (int i = F.tid; i < 64 * 16; i += NWAVES * 64) glr_l[i] = F.GLR[(size_t)m0 * 16 + i];
    float wg[16];
#pragma unroll
    for (int r = 0; r < 16; ++r) wg[r] = F.w_gate_up[r * 1024 + h * HK + kd];
    const float bg = F.b_gate[h * HK + kd];
#pragma unroll
    for (int r = 0; r < 4; ++r) { const int q = F.tid + 512 * r, row = q >> 5, c = q & 31; *(LAS v4u*)(QD + row * PREP_PITCH + 8 * c) = qraw[r]; *(LAS v4u*)(KD + row * PREP_PITCH + 8 * c) = kraw[r]; }
    LDS_BARRIER();
    float c[32]; float run = 0.f;
#pragma unroll
    for (int tt = 0; tt < 32; ++tt) { const int t = 32 * half + tt; float z = bg;
#pragma unroll
        for (int r4 = 0; r4 < 4; ++r4) { const f32x4 gv = *(const LAS f32x4*)(glr_l + t * 16 + 4 * r4); z += gv.x * wg[4 * r4] + gv.y * wg[4 * r4 + 1] + gv.z * wg[4 * r4 + 2] + gv.w * wg[4 * r4 + 3]; }
        run += log_sigmoid_f(z) * 0.0625f; c[tt] = run; }
    if (half == 0) tot[kd] = run;
    LDS_BARRIER();
    if (half == 1) { const float add = tot[kd];
#pragma unroll
        for (int tt = 0; tt < 32; ++tt) c[tt] += add;
        bref[kd] = c[0]; blast[kd] = c[31]; F.BLAST[(size_t)bh * HK + kd] = c[31]; }
    LDS_BARRIER();
    const float br = bref[kd], bl = blast[kd], ebr = __expf(br), ebl = __expf(bl - br);
    unsigned klp[16];
    bf16* qdst = F.QE + (size_t)(m0 + 32 * half) * 1024 + h * HK + kd;
#pragma unroll
    for (int tt = 0; tt < 32; tt += 2) { float klv[2];
#pragma unroll
        for (int e = 0; e < 2; ++e) { const int t = 32 * half + tt + e; const float e1 = __expf(c[tt + e] - br), r1 = __builtin_amdgcn_rcpf(e1);
            const float qv = bf2f(QD[t * PREP_PITCH + kd]), kv = bf2f(KD[t * PREP_PITCH + kd]);
            QD[t * PREP_PITCH + kd] = (bf16)f2bf(qv * e1); KD[t * PREP_PITCH + kd] = (bf16)f2bf(kv * r1);
            qdst[(size_t)(tt + e) * 1024] = (bf16)f2bf(qv * e1 * ebr);
            klv[e] = kv * r1 * ebl; }
        klp[tt >> 1] = pk2(klv[0], klv[1]); }
    { GAS v4u* kt = (GAS v4u*)(F.KLT + ((size_t)bh * HK + kd) * 64 + 32 * half);
#pragma unroll
      for (int i = 0; i < 4; ++i) { v4u w; w.x = klp[4 * i]; w.y = klp[4 * i + 1]; w.z = klp[4 * i + 2]; w.w = klp[4 * i + 3]; kt[i] = w; } }
    LDS_BARRIER();
    const int cl = F.lane & 15, g = F.lane >> 4;
#pragma unroll
    for (int rep = 0; rep < 2; ++rep) { const int tile = F.wave + 8 * rep, it = tile >> 2, jt = tile & 3; f32x4 acc = {0.f, 0.f, 0.f, 0.f};
        if (jt <= it) {
#pragma unroll
            for (int kk = 0; kk < 8; ++kk) { const bf16x8 a = *(const LAS bf16x8*)(KD + (16 * jt + cl) * PREP_PITCH + 32 * kk + 8 * g); const bf16x8 b = *(const LAS bf16x8*)(QD + (16 * it + cl) * PREP_PITCH + 32 * kk + 8 * g);
                acc = MFMA16(a, b, acc); } }
        const int i = 16 * it + cl, j0 = 16 * jt + 4 * g;
        v2u w; w.x = pk2(j0 <= i ? acc.x : 0.f, j0 + 1 <= i ? acc.y : 0.f); w.y = pk2(j0 + 2 <= i ? acc.z : 0.f, j0 + 3 <= i ? acc.w : 0.f);
        *(GAS v2u*)(F.ATT + (size_t)bh * 4096 + i * 64 + j0) = w; }
    LDS_BARRIER();
}
constexpr int VT_PITCH = 520;
static_assert(64 * VT_PITCH * 2 <= RING_BYTES, "vt LDS");
__device__ __forceinline__ void v_transpose_unit(Frame& F, int bh) {
    const int blk = bh >> 2, h = bh & 3, m0 = 64 * blk; LAS bf16* tile = (LAS bf16*)F.lds;
    { const int row = F.tid >> 3, piece = F.tid & 7; const GAS v4u* src = (const GAS v4u*)(F.PROJ + (size_t)(m0 + row) * NPROJ + C_VV + h * HV + piece * 64);
      LAS v4u* dst = (LAS v4u*)(tile + row * VT_PITCH + piece * 64);
#pragma unroll
      for (int i = 0; i < 8; ++i) dst[i] = src[i]; }
    LDS_BARRIER();
    { const int e = F.tid; unsigned p[32];
#pragma unroll
      for (int j = 0; j < 64; j += 2) p[j >> 1] = (unsigned)tile[j * VT_PITCH + e] | ((unsigned)tile[(j + 1) * VT_PITCH + e] << 16);
      GAS v4u* dst = (GAS v4u*)(F.VT + ((size_t)bh * HV + e) * 64);
#pragma unroll
      for (int i = 0; i < 8; ++i) { v4u w; w.x = p[4 * i]; w.y = p[4 * i + 1]; w.z = p[4 * i + 2]; w.w = p[4 * i + 3]; dst[i] = w; } }
    LDS_BARRIER();
}

constexpr int SGU_PITCH = 136;
struct SguPre { v4u vr[4]; v2u uw[8]; float s1, s2; };
__device__ __forceinline__ void sgu_prefetch(Frame& F, int un, SguPre& o) {
    const int ck = un >> 4, a = un & 15; const int m0 = ck < 128 ? 128 * ck : MP + 64 * (ck - 128), clen = ck < 128 ? 128 : 64;
    const int it = F.wave, cl = F.lane & 15, g = F.lane >> 4;
    const bool act = 16 * it < clen; const int i = act ? 16 * it + cl : 0;
    { const int j = F.tid >> 2, qd = F.tid & 3;
      if (j < clen) { const int m = m0 + j; const GAS v4u* src = (const GAS v4u*)(F.PROJ + (size_t)m * NPROJ + C_V + a * AHD + 32 * qd);
#pragma unroll
          for (int q = 0; q < 4; ++q) o.vr[q] = src[q];
          o.s1 = ((const float*)(F.ctl + CW_VST))[2 * m]; o.s2 = ((const float*)(F.ctl + CW_VST))[2 * m + 1]; } }
    { const bf16* urow = F.PROJ + (size_t)(m0 + i) * NPROJ + C_U + a * AHD + 4 * g;
#pragma unroll
      for (int dt = 0; dt < 8; ++dt) o.uw[dt] = *(const GAS v2u*)(urow + 16 * dt); }
}
struct SguW { v4u bw[4]; float bs; int a; float lg[32], lb[32]; };
__device__ __forceinline__ void sgu_unit(Frame& F, int un, SguPre& cur, int un_next, SguW& W) {
    const int ck = un >> 4, a = un & 15; const int m0 = ck < 128 ? 128 * ck : MP + 64 * (ck - 128), clen = ck < 128 ? 128 : 64;
    LAS bf16* VnT = (LAS bf16*)F.lds;
    const int it = F.wave, cl = F.lane & 15, g = F.lane >> 4;
    const bool act = 16 * it < clen; const int i = act ? 16 * it + cl : 0, nk = (it >> 1) + 1;
    if (W.a != a) {
        const int iw = 16 * it + cl;
#pragma unroll
        for (int kk = 0; kk < 4; ++kk) { const float* wrow = F.w_s + ((size_t)a * 128 + iw) * 128 + 32 * kk + 8 * g; const f32x4 w0 = *(const f32x4*)wrow, w1 = *(const f32x4*)(wrow + 4);
            const int j0 = 32 * kk + 8 * g;
            W.bw[kk].x = pk2(j0 <= iw ? w0.x : 0.f, j0 + 1 <= iw ? w0.y : 0.f); W.bw[kk].y = pk2(j0 + 2 <= iw ? w0.z : 0.f, j0 + 3 <= iw ? w0.w : 0.f);
            W.bw[kk].z = pk2(j0 + 4 <= iw ? w1.x : 0.f, j0 + 5 <= iw ? w1.y : 0.f); W.bw[kk].w = pk2(j0 + 6 <= iw ? w1.z : 0.f, j0 + 7 <= iw ? w1.w : 0.f); }
        W.bs = F.b_s[a * 128 + iw]; W.a = a;
        { const int qd = F.tid & 3; const f32x4* lg4 = (const f32x4*)(F.ln_g + a * AHD + 32 * qd); const f32x4* lb4 = (const f32x4*)(F.ln_b + a * AHD + 32 * qd);
#pragma unroll
          for (int q = 0; q < 8; ++q) { const f32x4 x = lg4[q], y = lb4[q]; W.lg[4 * q] = x.x; W.lg[4 * q + 1] = x.y; W.lg[4 * q + 2] = x.z; W.lg[4 * q + 3] = x.w; W.lb[4 * q] = y.x; W.lb[4 * q + 1] = y.y; W.lb[4 * q + 2] = y.z; W.lb[4 * q + 3] = y.w; } } }
    const float bs = W.bs;
    { const int j = F.tid >> 2, qd = F.tid & 3;
      if (j < clen) { const float mu = cur.s1 * (1.f / AWID), rs = 1.0f / sqrtf(fmaxf(cur.s2 * (1.f / AWID) - mu * mu, 0.f) + EPS);
#pragma unroll
          for (int q = 0; q < 4; ++q) { const v4u w = cur.vr[q]; const float f[8] = {bflo(w.x), bfhi(w.x), bflo(w.y), bfhi(w.y), bflo(w.z), bfhi(w.z), bflo(w.w), bfhi(w.w)};
#pragma unroll
              for (int k = 0; k < 8; ++k) { const int d = 8 * q + k; VnT[(32 * qd + d) * SGU_PITCH + j] = (bf16)f2bf((f[k] - mu) * rs * W.lg[d] + W.lb[d]); } } } }
    v2u uw[8];
#pragma unroll
    for (int dt = 0; dt < 8; ++dt) uw[dt] = cur.uw[dt];
    LDS_BARRIER();
    if (un_next >= 0) sgu_prefetch(F, un_next, cur);
    if (act) {
        f32x4 acc[8];
#pragma unroll
        for (int dt = 0; dt < 8; ++dt) acc[dt] = (f32x4){0.f, 0.f, 0.f, 0.f};
#pragma unroll
        for (int kk = 0; kk < 4; ++kk) if (kk < nk) {
            const bf16x8 bfrag = __builtin_bit_cast(bf16x8, W.bw[kk]);
#pragma unroll
            for (int dt = 0; dt < 8; ++dt) { const bf16x8 afrag = *(const LAS bf16x8*)(VnT + (16 * dt + cl) * SGU_PITCH + 32 * kk + 8 * g); acc[dt] = MFMA16(afrag, bfrag, acc[dt]); } }
        bf16* orow = F.MIX + (size_t)(m0 + i) * DM + a * AHD + 4 * g;
#pragma unroll
        for (int dt = 0; dt < 8; ++dt) {
            v2u w; w.x = pk2(bflo(uw[dt].x) * (acc[dt].x + bs), bfhi(uw[dt].x) * (acc[dt].y + bs)); w.y = pk2(bflo(uw[dt].y) * (acc[dt].z + bs), bfhi(uw[dt].y) * (acc[dt].w + bs));
            *(GAS v2u*)(orow + 16 * dt) = w; }
    }
    LDS_BARRIER();
}

struct ChainRegs { f32x4 S[2][4]; };
struct ChainOpsU { bf16x8 ka[2][2]; bf16x8 vb[4][2]; f32x4 bl[2]; };
struct ChainOpsO { bf16x8 qb[8]; bf16x8 ab[2]; };
__device__ __forceinline__ void chain_load_u(const Frame& F, int bh, int wv, int g, int cl, int es, ChainOpsU& P) {
#pragma unroll
    for (int dt = 0; dt < 2; ++dt)
#pragma unroll
        for (int kk = 0; kk < 2; ++kk) P.ka[dt][kk] = *(const GAS bf16x8*)(F.KLT + ((size_t)bh * HK + 32 * wv + 16 * dt + cl) * 64 + 32 * kk + 8 * g);
#pragma unroll
    for (int et = 0; et < 4; ++et)
#pragma unroll
        for (int kk = 0; kk < 2; ++kk) P.vb[et][kk] = *(const GAS bf16x8*)(F.VT + ((size_t)bh * HV + 64 * es + 16 * et + cl) * 64 + 32 * kk + 8 * g);
#pragma unroll
    for (int dt = 0; dt < 2; ++dt) P.bl[dt] = *(const GAS f32x4*)(F.BLAST + (size_t)bh * HK + 32 * wv + 16 * dt + 4 * g);
}
__device__ __forceinline__ void chain_load_o(const Frame& F, int blk, int h, int it, int g, int cl, ChainOpsO& P) {
    const bf16* qrow = F.QE + (size_t)(64 * blk + 16 * it + cl) * 1024 + h * HK + 8 * g;
#pragma unroll
    for (int kk = 0; kk < 8; ++kk) P.qb[kk] = *(const GAS bf16x8*)(qrow + 32 * kk);
#pragma unroll
    for (int kk = 0; kk < 2; ++kk) P.ab[kk] = *(const GAS bf16x8*)(F.ATT + (size_t)(blk * 4 + h) * 4096 + (16 * it + cl) * 64 + 32 * kk + 8 * g);
}
__device__ __forceinline__ void chain_update(ChainRegs& R, const ChainOpsU& P) {
#pragma unroll
    for (int dt = 0; dt < 2; ++dt) { f32x4 dec; dec.x = __expf(P.bl[dt].x); dec.y = __expf(P.bl[dt].y); dec.z = __expf(P.bl[dt].z); dec.w = __expf(P.bl[dt].w);
#pragma unroll
        for (int et = 0; et < 4; ++et) { f32x4 s = R.S[dt][et] * dec;
#pragma unroll
            for (int kk = 0; kk < 2; ++kk) s = MFMA16(P.ka[dt][kk], P.vb[et][kk], s);
            R.S[dt][et] = s; } }
}
__device__ __forceinline__ void chain_load(const float* base, int wv, int g, int cl, int es, ChainRegs& R) {
#pragma unroll
    for (int dt = 0; dt < 2; ++dt)
#pragma unroll
        for (int et = 0; et < 4; ++et) { const float* p = base + (size_t)(32 * wv + 16 * dt + 4 * g) * HV + 64 * es + 16 * et + cl;
            R.S[dt][et] = (f32x4){p[0], p[HV], p[2 * HV], p[3 * HV]}; }
}
__device__ __forceinline__ void chain_store(float* base, int wv, int g, int cl, int es, const ChainRegs& R) {
#pragma unroll
    for (int dt = 0; dt < 2; ++dt)
#pragma unroll
        for (int et = 0; et < 4; ++et) { float* p = base + (size_t)(32 * wv + 16 * dt + 4 * g) * HV + 64 * es + 16 * et + cl;
            p[0] = R.S[dt][et].x; p[HV] = R.S[dt][et].y; p[2 * HV] = R.S[dt][et].z; p[3 * HV] = R.S[dt][et].w; }
}
__device__ __forceinline__ void lst_store(float* base, int wv, int es, int lane, const ChainRegs& R) {
    GAS f32x4* p = (GAS f32x4*)base + ((size_t)(es * 8 + wv) * 8) * 64 + lane;
#pragma unroll
    for (int dt = 0; dt < 2; ++dt)
#pragma unroll
        for (int et = 0; et < 4; ++et) p[(dt * 4 + et) * 64] = R.S[dt][et];
}
__device__ __forceinline__ void lst_load(const float* base, int wv, int es, int lane, ChainRegs& R) {
    const GAS f32x4* p = (const GAS f32x4*)base + ((size_t)(es * 8 + wv) * 8) * 64 + lane;
#pragma unroll
    for (int dt = 0; dt < 2; ++dt)
#pragma unroll
        for (int et = 0; et < 4; ++et) R.S[dt][et] = p[(dt * 4 + et) * 64];
}
__device__ __forceinline__ void chain_decode(int un, int& gs, int& h, int& es) { const int x = un & 7, idx = (un >> 3) & 31, hi = un >> 8; const int gh = x * 4 + (idx >> 3); es = idx & 7; h = gh & 3; gs = hi * 8 + (gh >> 2); }
struct ChainOpsK1 { bf16x8 ka[2][2]; f32x4 bl[2]; };
__device__ __forceinline__ void chain_load_k1(const Frame& F, int bh, int wv, int g, int cl, ChainOpsK1& P) {
#pragma unroll
    for (int dt = 0; dt < 2; ++dt)
#pragma unroll
        for (int kk = 0; kk < 2; ++kk) P.ka[dt][kk] = *(const GAS bf16x8*)(F.KLT + ((size_t)bh * HK + 32 * wv + 16 * dt + cl) * 64 + 32 * kk + 8 * g);
#pragma unroll
    for (int dt = 0; dt < 2; ++dt) P.bl[dt] = *(const GAS f32x4*)(F.BLAST + (size_t)bh * HK + 32 * wv + 16 * dt + 4 * g);
}
constexpr int P1V_PITCH = 72;
__device__ __forceinline__ void chain_step_kv(ChainRegs& R, const ChainOpsK1& P, const LAS bf16* vimg, int g, int cl) {
    bf16x8 vb[4][2];
#pragma unroll
    for (int et = 0; et < 4; ++et)
#pragma unroll
        for (int kk = 0; kk < 2; ++kk) vb[et][kk] = *(const LAS bf16x8*)(vimg + (16 * et + cl) * P1V_PITCH + 32 * kk + 8 * g);
#pragma unroll
    for (int dt = 0; dt < 2; ++dt) { f32x4 dec; dec.x = __expf(P.bl[dt].x); dec.y = __expf(P.bl[dt].y); dec.z = __expf(P.bl[dt].z); dec.w = __expf(P.bl[dt].w);
#pragma unroll
        for (int et = 0; et < 4; ++et) { f32x4 s = R.S[dt][et] * dec;
#pragma unroll
            for (int kk = 0; kk < 2; ++kk) s = MFMA16(P.ka[dt][kk], vb[et][kk], s);
            R.S[dt][et] = s; } }
}
__device__ __forceinline__ void chain_pass1_unit(Frame& F, int un) {
    int gp, h, es; chain_decode(un, gp, h, es); const int wv = F.wave, g = F.lane >> 4, cl = F.lane & 15;
    if (gp >= NG - 1) return;
    ChainRegs R;
#pragma unroll
    for (int dt = 0; dt < 2; ++dt)
#pragma unroll
        for (int et = 0; et < 4; ++et) R.S[dt][et] = (f32x4){0.f, 0.f, 0.f, 0.f};
    f32x4 bsum[2] = {{0.f, 0.f, 0.f, 0.f}, {0.f, 0.f, 0.f, 0.f}};
    LAS bf16* VB = (LAS bf16*)F.lds;
    const int prow = 8 * wv + (F.lane >> 3), pcol = 8 * (F.lane & 7), poff = prow * P1V_PITCH + pcol;
    const bf16* pbase = F.VT + ((size_t)64 * es + prow) * 64 + pcol;
    ChainOpsK1 PA, PB; const int bh0 = (GB * gp) * 4 + h;
    bf16x8 pc0 = *(const GAS bf16x8*)(pbase + (size_t)bh0 * HV * 64), pc1 = *(const GAS bf16x8*)(pbase + (size_t)(bh0 + 4) * HV * 64);
    chain_load_k1(F, bh0, wv, g, cl, PA);
    *(LAS bf16x8*)(VB + poff) = pc0;
    LDS_BARRIER();
    for (int s = 0; s < GB; s += 2) {
        chain_load_k1(F, bh0 + 4 * (s + 1), wv, g, cl, PB);
        pc0 = *(const GAS bf16x8*)(pbase + (size_t)(bh0 + 4 * (s + 2 < GB ? s + 2 : s)) * HV * 64);
        *(LAS bf16x8*)(VB + 64 * P1V_PITCH + poff) = pc1;
        chain_step_kv(R, PA, VB, g, cl); bsum[0] += PA.bl[0]; bsum[1] += PA.bl[1];
        LDS_BARRIER();
        chain_load_k1(F, bh0 + 4 * (s + 2 < GB ? s + 2 : s), wv, g, cl, PA);
        pc1 = *(const GAS bf16x8*)(pbase + (size_t)(bh0 + 4 * (s + 3 < GB ? s + 3 : s)) * HV * 64);
        *(LAS bf16x8*)(VB + poff) = pc0;
        chain_step_kv(R, PB, VB + 64 * P1V_PITCH, g, cl); bsum[0] += PB.bl[0]; bsum[1] += PB.bl[1];
        LDS_BARRIER();
    }
    lst_store(F.LST + (size_t)(gp * 4 + h) * HK * HV, wv, es, F.lane, R);
    if (es == 0 && cl == 0) { *(GAS f32x4*)(F.GDEC + (size_t)(gp * 4 + h) * HK + 32 * wv + 4 * g) = bsum[0]; *(GAS f32x4*)(F.GDEC + (size_t)(gp * 4 + h) * HK + 32 * wv + 16 + 4 * g) = bsum[1]; }
}
constexpr int SL_PITCH = 264, SL_BYTES = 64 * SL_PITCH * 2, AL_PITCH = 72, AL_BYTES = 64 * AL_PITCH * 2;
constexpr int CH_SL = 0, CH_QL = SL_BYTES, CH_AL = 2 * SL_BYTES, CH_VL = CH_AL + AL_BYTES, CH_END = CH_VL + AL_BYTES;
static_assert(CH_END <= RING_BYTES, "chain LDS");
struct ChainStage { v4u q[4]; v4u a; v4u v; };
struct ChainOpsK { bf16x8 ka[2][2]; f32x4 bl[2]; };
__device__ __forceinline__ void chain_stage_load(const Frame& F, int blk, int h, int es, ChainStage& T) {
    const int bh = blk * 4 + h;
#pragma unroll
    for (int k = 0; k < 4; ++k) { const int q = F.tid + 512 * k, row = q >> 5, c = q & 31; T.q[k] = *(const GAS v4u*)(F.QE + (size_t)(64 * blk + row) * 1024 + h * HK + 8 * c); }
    const int row = F.tid >> 3, c = F.tid & 7;
    T.a = *(const GAS v4u*)(F.ATT + (size_t)bh * 4096 + row * 64 + 8 * c);
    T.v = *(const GAS v4u*)(F.VT + ((size_t)bh * HV + 64 * es + row) * 64 + 8 * c);
}
__device__ __forceinline__ void chain_stage_write(const Frame& F, const ChainStage& T) {
#pragma unroll
    for (int k = 0; k < 4; ++k) { const int q = F.tid + 512 * k, row = q >> 5, c = q & 31; *(LAS v4u*)(F.lds + CH_QL + (row * SL_PITCH + 8 * c) * 2) = T.q[k]; }
    const int row = F.tid >> 3, c = F.tid & 7;
    *(LAS v4u*)(F.lds + CH_AL + (row * AL_PITCH + 8 * c) * 2) = T.a;
    *(LAS v4u*)(F.lds + CH_VL + (row * AL_PITCH + 8 * c) * 2) = T.v;
}
__device__ __forceinline__ void chain_load_k(const Frame& F, int bh, int wv, int g, int cl, ChainOpsK& P) {
#pragma unroll
    for (int dt = 0; dt < 2; ++dt)
#pragma unroll
        for (int kk = 0; kk < 2; ++kk) P.ka[dt][kk] = *(const GAS bf16x8*)(F.KLT + ((size_t)bh * HK + 32 * wv + 16 * dt + cl) * 64 + 32 * kk + 8 * g);
#pragma unroll
    for (int dt = 0; dt < 2; ++dt) P.bl[dt] = *(const GAS f32x4*)(F.BLAST + (size_t)bh * HK + 32 * wv + 16 * dt + 4 * g);
}
__device__ __forceinline__ void chain_write_sl(LAS unsigned char* sl, int wv, int g, int cl, const ChainRegs& R) {
#pragma unroll
    for (int dt = 0; dt < 2; ++dt)
#pragma unroll
        for (int et = 0; et < 4; ++et) { v2u w; w.x = pk2(R.S[dt][et].x, R.S[dt][et].y); w.y = pk2(R.S[dt][et].z, R.S[dt][et].w);
            *(LAS v2u*)(sl + ((16 * et + cl) * SL_PITCH + 32 * wv + 16 * dt + 4 * g) * 2) = w; }
}
__device__ __forceinline__ void chain_step_compute(Frame& F, int blk, int h, int es, ChainRegs& R, const ChainOpsK& PK) {
    const int wv = F.wave, g = F.lane >> 4, cl = F.lane & 15, it = wv >> 1, eh = wv & 1;
    const LAS unsigned char* sl = F.lds + CH_SL; const LAS unsigned char* ql = F.lds + CH_QL; const LAS unsigned char* al = F.lds + CH_AL; const LAS unsigned char* vl = F.lds + CH_VL;
    f32x4 o0 = {0.f, 0.f, 0.f, 0.f}, o1 = {0.f, 0.f, 0.f, 0.f};
#pragma unroll 1
    for (int k2 = 0; k2 < 8; k2 += 2) {
#pragma unroll
        for (int kq = 0; kq < 2; ++kq) { const int kk = k2 + kq; const bf16x8 qb = *(const LAS bf16x8*)(ql + ((16 * it + cl) * SL_PITCH + 32 * kk + 8 * g) * 2);
            const bf16x8 s0 = *(const LAS bf16x8*)(sl + ((16 * (2 * eh) + cl) * SL_PITCH + 32 * kk + 8 * g) * 2), s1 = *(const LAS bf16x8*)(sl + ((16 * (2 * eh + 1) + cl) * SL_PITCH + 32 * kk + 8 * g) * 2);
            o0 = MFMA16(s0, qb, o0); o1 = MFMA16(s1, qb, o1); } }
#pragma unroll
    for (int kk = 0; kk < 2; ++kk) { const bf16x8 ab = *(const LAS bf16x8*)(al + ((16 * it + cl) * AL_PITCH + 32 * kk + 8 * g) * 2);
        const bf16x8 v0 = *(const LAS bf16x8*)(vl + ((16 * (2 * eh) + cl) * AL_PITCH + 32 * kk + 8 * g) * 2), v1 = *(const LAS bf16x8*)(vl + ((16 * (2 * eh + 1) + cl) * AL_PITCH + 32 * kk + 8 * g) * 2);
        o0 = MFMA16(v0, ab, o0); o1 = MFMA16(v1, ab, o1); }
    { bf16* orow = F.O + (size_t)(64 * blk + 16 * it + cl) * 2048 + h * HV + 64 * es + 32 * eh + 4 * g;
      v2u w; w.x = pk2(o0.x, o0.y); w.y = pk2(o0.z, o0.w); *(GAS v2u*)orow = w; w.x = pk2(o1.x, o1.y); w.y = pk2(o1.z, o1.w); *(GAS v2u*)(orow + 16) = w; }
    f32x4 dec[2];
#pragma unroll
    for (int dt = 0; dt < 2; ++dt) { dec[dt].x = __expf(PK.bl[dt].x); dec[dt].y = __expf(PK.bl[dt].y); dec[dt].z = __expf(PK.bl[dt].z); dec[dt].w = __expf(PK.bl[dt].w); }
#pragma unroll
    for (int et = 0; et < 4; ++et) {
        const bf16x8 vb0 = *(const LAS bf16x8*)(vl + ((16 * et + cl) * AL_PITCH + 8 * g) * 2), vb1 = *(const LAS bf16x8*)(vl + ((16 * et + cl) * AL_PITCH + 32 + 8 * g) * 2);
#pragma unroll
        for (int dt = 0; dt < 2; ++dt) { f32x4 s = R.S[dt][et] * dec[dt]; s = MFMA16(PK.ka[dt][0], vb0, s); s = MFMA16(PK.ka[dt][1], vb1, s); R.S[dt][et] = s; }
        __builtin_amdgcn_sched_barrier(0); }
}
__device__ __forceinline__ void chain_steps_o(Frame& F, int blk0, int nsteps, int h, int es, ChainRegs& R) {
    const int wv = F.wave, g = F.lane >> 4, cl = F.lane & 15, last = blk0 + nsteps - 1;
    ChainStage TA, TB; ChainOpsK K;
    chain_stage_load(F, blk0, h, es, TA); chain_load_k(F, blk0 * 4 + h, wv, g, cl, K);
    { const int b1 = blk0 + 1 <= last ? blk0 + 1 : last; chain_stage_load(F, b1, h, es, TB); }
    chain_write_sl(F.lds + CH_SL, wv, g, cl, R); chain_stage_write(F, TA);
    LDS_BARRIER();
    if (nsteps == 1) { chain_step_compute(F, blk0, h, es, R, K); LDS_BARRIER(); return; }
    for (int s = 0; s < nsteps; s += 2) {
        { const int b1 = blk0 + s + 1, b2 = blk0 + s + 2 <= last ? blk0 + s + 2 : last; chain_stage_load(F, b2, h, es, TA);
          chain_step_compute(F, blk0 + s, h, es, R, K);
          chain_load_k(F, b1 * 4 + h, wv, g, cl, K); }
        LDS_BARRIER();
        chain_write_sl(F.lds + CH_SL, wv, g, cl, R); chain_stage_write(F, TB);
        LDS_BARRIER();
        { const int b2 = blk0 + s + 2 <= last ? blk0 + s + 2 : last, b3 = blk0 + s + 3 <= last ? blk0 + s + 3 : last; chain_stage_load(F, b3, h, es, TB);
          chain_step_compute(F, blk0 + s + 1, h, es, R, K);
          chain_load_k(F, b2 * 4 + h, wv, g, cl, K); }
        LDS_BARRIER();
        chain_write_sl(F.lds + CH_SL, wv, g, cl, R); chain_stage_write(F, TA);
        LDS_BARRIER();
    }
}
__device__ __forceinline__ void chain_pass2_prompt_unit(Frame& F, int un) {
    int gp, h, es; chain_decode(un, gp, h, es); const int wv = F.wave, g = F.lane >> 4, cl = F.lane & 15;
    ChainRegs R;
#pragma unroll
    for (int dt = 0; dt < 2; ++dt)
#pragma unroll
        for (int et = 0; et < 4; ++et) R.S[dt][et] = (f32x4){0.f, 0.f, 0.f, 0.f};
    ChainRegs LA; f32x4 ga[2];
    if (gp > 0) { lst_load(F.LST + (size_t)h * HK * HV, wv, es, F.lane, LA);
#pragma unroll
        for (int dt = 0; dt < 2; ++dt) ga[dt] = *(const GAS f32x4*)(F.GDEC + (size_t)h * HK + 32 * wv + 16 * dt + 4 * g); }
    for (int q = 0; q < gp; ++q) {
        ChainRegs LB; f32x4 gb[2]; const int qn = q + 1 < gp ? q + 1 : q;
        lst_load(F.LST + (size_t)(qn * 4 + h) * HK * HV, wv, es, F.lane, LB);
#pragma unroll
        for (int dt = 0; dt < 2; ++dt) gb[dt] = *(const GAS f32x4*)(F.GDEC + (size_t)(qn * 4 + h) * HK + 32 * wv + 16 * dt + 4 * g);
#pragma unroll
        for (int dt = 0; dt < 2; ++dt) { const f32x4 gd = ga[dt];
            f32x4 dec; dec.x = __expf(gd.x); dec.y = __expf(gd.y); dec.z = __expf(gd.z); dec.w = __expf(gd.w);
#pragma unroll
            for (int et = 0; et < 4; ++et) R.S[dt][et] = R.S[dt][et] * dec + LA.S[dt][et]; }
#pragma unroll
        for (int dt = 0; dt < 2; ++dt) { ga[dt] = gb[dt];
#pragma unroll
            for (int et = 0; et < 4; ++et) LA.S[dt][et] = LB.S[dt][et]; } }
    chain_steps_o(F, GB * gp, GB, h, es, R);
    if (gp == NG - 1) chain_store(F.out + O_GP + (size_t)h * HK * HV, wv, g, cl, es, R);
}
__device__ __forceinline__ void chain_sample_unit(Frame& F, int un) {
    int st, h, es; chain_decode(un, st, h, es); const int wv = F.wave, g = F.lane >> 4, cl = F.lane & 15;
    ChainRegs R; chain_load(F.state_gla + (size_t)(st * 4 + h) * HK * HV, wv, g, cl, es, R);
    chain_steps_o(F, MP / 64 + st, 1, h, es, R);
    chain_store(F.out + O_GS + (size_t)(st * 4 + h) * HK * HV, wv, g, cl, es, R);
}

__device__ __forceinline__ void gla_finish_load(const Frame& F, int m, v4u (&w)[4], v4u (&rw)[4]) {
    const GAS v4u* orow = (const GAS v4u*)(F.O + (size_t)m * 2048) + F.lane; const GAS v4u* rrow = (const GAS v4u*)(F.PROJ + (size_t)m * NPROJ + C_R) + F.lane;
#pragma unroll
    for (int hh = 0; hh < 4; ++hh) { w[hh] = orow[64 * hh]; rw[hh] = rrow[64 * hh]; }
}
__device__ __forceinline__ void gla_finish_rows(Frame& F, int gw, int NGW) {
    const f32x4 g0 = *(const f32x4*)(F.gla_norm_g + 8 * F.lane), g1 = *(const f32x4*)(F.gla_norm_g + 8 * F.lane + 4);
    v4u wA[4], rA[4];
    if (gw < M) gla_finish_load(F, gw, wA, rA);
    for (int m = gw; m < M; m += NGW) {
        v4u wB[4], rB[4]; const int mn = m + NGW < M ? m + NGW : m;
        gla_finish_load(F, mn, wB, rB);
        GAS v4u* drow = (GAS v4u*)(F.MIX + (size_t)m * DM + 2048) + F.lane;
#pragma unroll
        for (int hh = 0; hh < 4; ++hh) { const v4u w = wA[hh], rw = rA[hh];
            const float f[8] = {bflo(w.x), bfhi(w.x), bflo(w.y), bfhi(w.y), bflo(w.z), bfhi(w.z), bflo(w.w), bfhi(w.w)};
            const float r[8] = {bflo(rw.x), bfhi(rw.x), bflo(rw.y), bfhi(rw.y), bflo(rw.z), bfhi(rw.z), bflo(rw.w), bfhi(rw.w)};
            float s = 0.f;
#pragma unroll
            for (int k = 0; k < 8; ++k) s += f[k] * f[k];
            const float rstd = 1.0f / sqrtf(wave_sum(s) * (1.f / HV) + EPS);
            v4u ow; ow.x = pk2hw(f[0] * rstd * g0.x * r[0], f[1] * rstd * g0.y * r[1]); ow.y = pk2hw(f[2] * rstd * g0.z * r[2], f[3] * rstd * g0.w * r[3]);
            ow.z = pk2hw(f[4] * rstd * g1.x * r[4], f[5] * rstd * g1.y * r[5]); ow.w = pk2hw(f[6] * rstd * g1.z * r[6], f[7] * rstd * g1.w * r[7]);
            drow[64 * hh] = ow; }
#pragma unroll
        for (int hh = 0; hh < 4; ++hh) { wA[hh] = wB[hh]; rA[hh] = rB[hh]; }
    }
}
__device__ __forceinline__ void final_norm_rows(Frame& F, int gw, int NGW) {
    const GAS f32x4* gr = (const GAS f32x4*)F.g_final; f32x4 g0[8], g1[8];
#pragma unroll
    for (int j = 0; j < 8; ++j) { const int c4 = 2 * (F.lane + 64 * j); g0[j] = gr[c4]; g1[j] = gr[c4 + 1]; }
    const float* ssq = (const float*)(F.ctl + CW_SSQ2);
    v4u wA[8]; float sA = 0.f;
    if (gw < M) { const GAS v4u* xr = (const GAS v4u*)(F.HN + (size_t)gw * DM) + F.lane; sA = ssq[gw];
#pragma unroll
        for (int j = 0; j < 8; ++j) wA[j] = xr[64 * j]; }
    for (int m = gw; m < M; m += NGW) {
        const int mn = m + NGW < M ? m + NGW : m; v4u wB[8];
        const GAS v4u* xn = (const GAS v4u*)(F.HN + (size_t)mn * DM) + F.lane; const float sB = ssq[mn];
#pragma unroll
        for (int j = 0; j < 8; ++j) wB[j] = xn[64 * j];
        GAS f32x4* yr = (GAS f32x4*)(F.out + (size_t)m * DM);
        const float rstd = 1.0f / sqrtf(sA * (1.f / DM) + EPS);
#pragma unroll
        for (int j = 0; j < 8; ++j) { const int c4 = 2 * (F.lane + 64 * j);
            f32x4 y0, y1; y0.x = bflo(wA[j].x) * rstd * g0[j].x; y0.y = bfhi(wA[j].x) * rstd * g0[j].y; y0.z = bflo(wA[j].y) * rstd * g0[j].z; y0.w = bfhi(wA[j].y) * rstd * g0[j].w;
            y1.x = bflo(wA[j].z) * rstd * g1[j].x; y1.y = bfhi(wA[j].z) * rstd * g1[j].y; y1.z = bflo(wA[j].w) * rstd * g1[j].z; y1.w = bfhi(wA[j].w) * rstd * g1[j].w;
            yr[c4] = y0; yr[c4 + 1] = y1; }
#pragma unroll
        for (int j = 0; j < 8; ++j) wA[j] = wB[j];
        sA = sB;
    }
}

#ifndef P9_WGM
#define P9_WGM 4
#endif
#ifndef GWGM
#define GWGM 9
#endif
#ifndef GWGM_P1
#define GWGM_P1 GWGM
#endif
#ifndef ALIGN_P6
#define ALIGN_P6 true
#endif
#ifndef GEMM_SP2
#define GEMM_SP2 true
#endif
#ifndef ALIGN_P1
#define ALIGN_P1 true
#endif
#ifndef ALIGN_P8
#define ALIGN_P8 true
#endif
#define PHASE_BEGIN(k) _Pragma("unroll") for (int _rep = 0; _rep < 1; ++_rep) {
#define PHASE_END(k) xcd_barrier(bar); }
struct Args { const float* in[18]; float* out; unsigned char* ws; };
__global__ void __launch_bounds__(NWAVES * 64, 2) fwd_kernel(Args args) {
    extern __shared__ __attribute__((aligned(16))) unsigned char lds[];
    Frame F;
    F.lds = (LAS unsigned char*)lds;
    F.tid = threadIdx.x; F.lane = F.tid & 63; F.wave = __builtin_amdgcn_readfirstlane(F.tid >> 6); F.G = gridDim.x; F.wg = blockIdx.x;
    unsigned char* ws = args.ws;
    F.ctl = (unsigned*)(ws + WS_CTL);
    F.x_prompt = args.in[0]; F.x_sample = args.in[1]; F.state_gla = args.in[2]; F.g_mix = args.in[3]; F.w_in = args.in[4]; F.w_s = args.in[5]; F.b_s = args.in[6]; F.ln_g = args.in[7]; F.ln_b = args.in[8];
    F.w_gate_up = args.in[9]; F.b_gate = args.in[10]; F.gla_norm_g = args.in[11]; F.w_out = args.in[12]; F.g_ffn = args.in[13]; F.w_ffn_gate = args.in[14]; F.w_ffn_up = args.in[15]; F.w_ffn_down = args.in[16]; F.g_final = args.in[17];
    F.out = args.out;
    F.WIN = (bf16*)(ws + WS_WIN); F.WOUT = (bf16*)(ws + WS_WOUT); F.WGU = (bf16*)(ws + WS_WGU); F.WDN = (bf16*)(ws + WS_WDN); F.HN = (bf16*)(ws + WS_HN); F.PROJ = (bf16*)(ws + WS_PROJ);
    F.MIX = (bf16*)(ws + WS_MIX); F.QE = (bf16*)(ws + WS_QE); F.KLT = (bf16*)(ws + WS_KLT); F.ATT = (bf16*)(ws + WS_ATT); F.VT = (bf16*)(ws + WS_VT); F.O = (bf16*)(ws + WS_O); F.HFF = (bf16*)(ws + WS_HFF);
    F.GLR = (float*)(ws + WS_GLR); F.STATS = (float*)(ws + WS_STATS); F.BLAST = (float*)(ws + WS_BLAST); F.LST = (float*)(ws + WS_LST); F.GDEC = (float*)(ws + WS_GDEC);
    for (int u = F.tid; u < (LDS_BYTES - PHASE_LDS) / 4; u += NWAVES * 64) ((LAS unsigned*)(F.lds + PHASE_LDS))[u] = 0u;
    __syncthreads();
    XcdBarrier bar = xcd_barrier_post(F.ctl + CW_BAR, (volatile LAS unsigned*)(F.lds + MISC_OFF + 32));
    const int gw = F.wg * NWAVES + F.wave, NGW = F.G * NWAVES;
    if (F.tid == 0) ((volatile LAS unsigned*)(F.lds + MISC_OFF))[0] = __hip_atomic_fetch_add(F.ctl + CW_XRANK + 16 * bar.x, 1u, __ATOMIC_RELAXED, __HIP_MEMORY_SCOPE_AGENT);
    F.wgv = F.wg;

    PHASE_BEGIN(0)
    p0_prologue(F);
    PHASE_END(0)
    {
        volatile LAS unsigned* misc = (volatile LAS unsigned*)(F.lds + MISC_OFF);
        if (F.tid == 0) { bool even = (F.G % 8) == 0; for (int j = 0; j < 8; ++j) even = even && (__hip_atomic_load(F.ctl + CW_XRANK + 16 * j, __ATOMIC_RELAXED, __HIP_MEMORY_SCOPE_AGENT) == (unsigned)(F.G / 8));
            misc[1] = (even && bar.x < 8u) ? bar.x + 8u * misc[0] : (unsigned)F.wg; }
        __syncthreads();
        F.wgv = __builtin_amdgcn_readfirstlane((int)misc[1]);
    }
    PHASE_BEGIN(1)
    { constexpr int FFN_END = P0_I_OUT + 2 * P0_I_G + P0_I_D;
      const int GG = F.G == 256 ? F.G - 8 : F.G;
      if (F.wgv >= GG) convert_items_pipelined(F, FFN_END - P0_MOVED - P1_DED, FFN_END - P0_MOVED, (F.wgv - GG) * NWAVES + F.wave, (F.G - GG) * NWAVES);
      else {
      pg8::Gemm g{F.HN, F.WIN, M, NPAD, DM}; pg8::StaticOrder S; S.init(M, NPAD, GG, F.wgv, GWGM_P1); pg8::EpiProj E{F.PROJ, F.GLR, (float*)(F.ctl + CW_VST)};
      pg8::gemm_phase<pg8::EpiProj, pg8::StaticOrder, ALIGN_P1, GEMM_SP2>(F.lds, g, S, E);
      { const int nwg = (M / 256) * (NPAD / 256), full = nwg / GG, T = nwg - full * GG, nidle = T > 0 ? GG - T : GG, rank = T > 0 ? F.wgv - T : F.wgv;
        if (rank >= 0) convert_items(F, FFN_END - P0_MOVED, FFN_END, rank * NWAVES + F.wave, nidle * NWAVES); } } }
    PHASE_END(1)
    PHASE_BEGIN(2)
#pragma unroll
    for (int rp = 0; rp < 1; ++rp) { for (int m = MP + gw; m < M; m += NGW) ln_sample_row(F, m); }
#pragma unroll
    for (int rp = 0; rp < 1; ++rp) { for (int u = F.wg; u < 2 * NBH; u += F.G) { if (u < NBH) gla_prep_unit(F, u); else v_transpose_unit(F, u - NBH); } }
    PHASE_END(2)
    PHASE_BEGIN(3)
#pragma unroll
    for (int rp = 0; rp < 1; ++rp) { for (int u = F.wgv; u < NG * 32; u += F.G) chain_pass1_unit(F, u); }
    PHASE_END(3)
    PHASE_BEGIN(4)
#pragma unroll
    for (int rp = 0; rp < 1; ++rp) { for (int u = F.wgv; u < NG * 32; u += F.G) chain_pass2_prompt_unit(F, u); }
#pragma unroll
    for (int rp = 0; rp < 1; ++rp) { for (int u = F.wgv; u < 32 * 32; u += F.G) chain_sample_unit(F, u); }
    PHASE_END(4)
    PHASE_BEGIN(5)
    gla_finish_rows(F, gw, NGW);
    __syncthreads();
#pragma unroll
    for (int rp = 0; rp < 1; ++rp) { SguPre sp; SguW sw; sw.a = -1; if (F.wg < 160 * 16) sgu_prefetch(F, F.wg, sp); for (int u = F.wg; u < 160 * 16; u += F.G) sgu_unit(F, u, sp, u + F.G < 160 * 16 ? u + F.G : -1, sw); }
    PHASE_END(5)
    PHASE_BEGIN(6)
    { int rounds, T, P; pg8::split_plan((M / 256) * (DM / 256), F.G, 4, rounds, T, P);
      pg8::Gemm g{F.MIX, F.WOUT, M, DM, DM}; pg8::StaticOrder S; S.init(M, DM, F.G, F.wgv, GWGM); S.imax = rounds; pg8::EpiResidNorm E{F.x_prompt, F.x_sample, MP, F.out, F.HN, F.g_ffn, (float*)(F.ctl + CW_SSQ)};
      pg8::gemm_phase<pg8::EpiResidNorm, pg8::StaticOrder, ALIGN_P6, GEMM_SP2>(F.lds, g, S, E);
      if (T > 0) { pg8::Gemm g2{F.MIX, F.WOUT, M, DM, DM / P, DM}; pg8::TailOrder TO; TO.init(M, DM, F.G, F.wgv, GWGM); TO.base = rounds * F.G; TO.T = T; TO.P = P;
          pg8::EpiPublish E2; E2.slab = (float*)(args.ws + WS_SLAB); E2.flags = F.ctl + CW_FLAG + 4096 * 0; E2.nparts = P;
          pg8::gemm_phase<pg8::EpiPublish, pg8::TailOrder, true, GEMM_SP2>(F.lds, g2, TO, E2);
          pg8::tail_combine(TO, E, E2.slab, E2.flags, P); } }
    PHASE_END(6)
    PHASE_BEGIN(8)
    { int rounds, T, P; pg8::split_plan((M / 256) * (2 * DFF / 256), F.G, 4, rounds, T, P);
      pg8::Gemm g{F.HN, F.WGU, M, 2 * DFF, DM}; pg8::StaticOrder S; S.init(M, 2 * DFF, F.G, F.wgv, GWGM); S.imax = rounds; pg8::EpiSwiglu E{F.HFF, (const float*)(F.ctl + CW_SSQ)};
      pg8::gemm_phase<pg8::EpiSwiglu, pg8::StaticOrder, ALIGN_P8, GEMM_SP2>(F.lds, g, S, E);
      if (T > 0) { pg8::Gemm g2{F.HN, F.WGU, M, 2 * DFF, DM / P, DM}; pg8::TailOrder TO; TO.init(M, 2 * DFF, F.G, F.wgv, GWGM); TO.base = rounds * F.G; TO.T = T; TO.P = P;
          pg8::EpiPublish E2{(float*)(args.ws + WS_SLAB), F.ctl + CW_FLAG + 4096 * 1, P};
          pg8::gemm_phase<pg8::EpiPublish, pg8::TailOrder, true, GEMM_SP2>(F.lds, g2, TO, E2);
          pg8::tail_combine(TO, E, E2.slab, E2.flags, P); } }
    PHASE_END(8)
    PHASE_BEGIN(9)
    { int rounds, T, P; pg8::split_plan((M / 256) * (DM / 256), F.G, 2, rounds, T, P);
      pg8::Gemm g{F.HFF, F.WDN, M, DM, DFF}; pg8::StaticOrder S; S.init(M, DM, F.G, F.wgv, P9_WGM); S.imax = rounds; pg8::EpiResidFinal E{F.HN, F.g_ffn, (float*)(F.ctl + CW_SSQ2)};
      pg8::gemm_phase<pg8::EpiResidFinal, pg8::StaticOrder, ALIGN_P6, GEMM_SP2>(F.lds, g, S, E);
      if (T > 0) { pg8::Gemm g2{F.HFF, F.WDN, M, DM, DFF / P, DFF}; pg8::TailOrder TO; TO.init(M, DM, F.G, F.wgv, P9_WGM); TO.base = rounds * F.G; TO.T = T; TO.P = P;
          pg8::EpiPublish E2; E2.slab = (float*)(args.ws + WS_SLAB); E2.flags = F.ctl + CW_FLAG + 4096 * 2; E2.nparts = P;
          pg8::gemm_phase<pg8::EpiPublish, pg8::TailOrder, true, GEMM_SP2>(F.lds, g2, TO, E2);
          pg8::tail_combine(TO, E, E2.slab, E2.flags, P); } }
    PHASE_END(9)
    PHASE_BEGIN(10)
    final_norm_rows(F, gw, NGW);
    }
}

extern "C" void kernel_launch(void* const* d_in, const int* in_sizes, int n_in, void* d_out, int out_size, void* d_ws, size_t ws_size, hipStream_t stream) {
    static int grid = 0;
    if (grid == 0) {
        if (n_in != 18 || (size_t)out_size != O_END || ws_size < WS_END) { fprintf(stderr, "kernel_launch: unexpected shapes (n_in %d, out %d, ws %zu < %zu); nothing launched\n", n_in, out_size, ws_size, (size_t)WS_END); grid = -1; return; }
        int dev = 0, cus = 0, per_cu = 0;
        if (hipGetDevice(&dev) != hipSuccess || hipDeviceGetAttribute(&cus, hipDeviceAttributeMultiprocessorCount, dev) != hipSuccess) { grid = -1; return; }
        if (hipFuncSetAttribute((const void*)fwd_kernel, hipFuncAttributeMaxDynamicSharedMemorySize, LDS_BYTES) != hipSuccess) { fprintf(stderr, "kernel_launch: hipFuncSetAttribute failed\n"); grid = -1; return; }
        if (hipOccupancyMaxActiveBlocksPerMultiprocessor(&per_cu, (const void*)fwd_kernel, NWAVES * 64, LDS_BYTES) != hipSuccess || per_cu < 1)
            fprintf(stderr, "kernel_launch: note: occupancy query reports %d workgroups per CU\n", per_cu);
        (void)hipGetLastError();
        grid = cus;
    }
    if (grid < 0) return;
    if (hipMemsetAsync((char*)d_ws + WS_CTL, 0, CTL_ZERO_BYTES, stream) != hipSuccess) return;
    Args a{};
    for (int i = 0; i < 18; ++i) a.in[i] = (const float*)d_in[i];
    a.out = (float*)d_out; a.ws = (unsigned char*)d_ws;
    hipLaunchKernelGGL(fwd_kernel, dim3(grid), dim3(NWAVES * 64), LDS_BYTES, stream, a);
}
```

```cpp
#include <hip/hip_runtime.h>
#include <cstdio>
#include <cstdint>

namespace pg8 {
#define PG8_LAS __attribute__((address_space(3)))
typedef unsigned short bf16_t;
typedef short bf16x8 __attribute__((ext_vector_type(8)));
typedef float f32x4 __attribute__((ext_vector_type(4)));
typedef unsigned u32x4 __attribute__((ext_vector_type(4)));
typedef unsigned u32x2 __attribute__((ext_vector_type(2)));
constexpr int BM = 256, BK = 64, HALF = 128, HTB = HALF * BK * 2  , STAGE_BYTES = 8 * HTB, NXCD = 8, WGM = 8;

__host__ __device__ __forceinline__ int lds_byte(int r, int c) { const int st = (r >> 4) * 2 + (c >> 5), rr = r & 15, cc = c & 31, ob = rr * 64 + cc * 2; return st * 1024 + (ob ^ (((ob >> 9) & 1) << 5)); }
__host__ __device__ __forceinline__ void stage_rc(int b, int& R, int& C) { const int st = b / 1024, sb = b % 1024, swz = sb ^ (((sb >> 9) & 1) << 5); R = (st >> 1) * 16 + swz / 64; C = (st & 1) * 32 + (swz % 64) / 2; }
__host__ __device__ __forceinline__ int perm32(int rho) { const int n = rho >> 4, i = rho & 15; return 8 * (i >> 2) + 4 * n + (i & 3); }

struct Unit { int pm, pn, kp, tt; };
struct Gemm { const bf16_t* A; const bf16_t* Bt; int M, N, K; int ld = 0; };

struct StaticOrder {
    int nM, nN, nwg, G, c, wgm, imax;
    __host__ __device__ void init(int M, int N, int G_, int c_, int wgm_ = WGM) { nM = M / BM; nN = N / BM; nwg = nM * nN; G = G_; c = c_; wgm = wgm_; imax = 1 << 30; }
    __host__ __device__ void tile_of(long L, Unit& u) const {
        if (wgm < 0) { const int xcd = (int)(L % NXCD), off = (int)(L / NXCD), w = nN / NXCD; u.pm = off / w; u.pn = xcd * w + off % w; u.kp = 0; u.tt = 0; return; }
        int wgid = (int)L; { const int q = nwg / NXCD, r = nwg % NXCD, xcd = wgid % NXCD, off = wgid / NXCD; wgid = (xcd < r ? xcd * (q + 1) : r * (q + 1) + (xcd - r) * q) + off; }
        const int nig = wgm * nN, gid = wgid / nig, fm = gid * wgm, gsz = (nM - fm) < wgm ? (nM - fm) : wgm;
        u.pm = fm + ((wgid % nig) % gsz); u.pn = (wgid % nig) / gsz; u.kp = 0; u.tt = 0;
    }
    __host__ __device__ bool next(int i, Unit& u) const { const long L = (long)i * G + c; if (L >= nwg || i >= imax) return false; tile_of(L, u); return true; }
    __device__ __forceinline__ void a_ready(const Unit&) const {}
    __device__ __forceinline__ void done(const Unit&) const {}
};
struct TailOrder : StaticOrder {
    int base, T, P;
    __host__ __device__ bool next(int i, Unit& u) const { if (i > 0 || c >= T * P) return false; const int tt = c % T; tile_of((long)base + tt, u); u.kp = c / T; u.tt = tt; return true; }
};
__host__ __device__ __forceinline__ void split_plan(int nwg, int G, int maxP, int& rounds, int& T, int& P) { rounds = nwg / G; T = nwg - rounds * G; P = 1; if (T > 0) { const int q = G / T; P = q >= 4 ? 4 : (q >= 2 ? 2 : 1); if (P > maxP) P = maxP; } if (P < 2) { if (T > 0) ++rounds; T = 0; } }

__device__ __forceinline__ unsigned cvt_pk_bf16(float lo, float hi) { unsigned r; asm volatile("v_cvt_pk_bf16_f32 %0, %1, %2" : "=v"(r) : "v"(lo), "v"(hi)); return r; }
__device__ __forceinline__ float x_sigmoid(float x, float t) { return x * __builtin_amdgcn_rcpf(1.0f + __builtin_amdgcn_exp2f(-1.4426950408889634f * t)); }
__device__ __forceinline__ float gelu_tanh(float x) { const float u = 0.7978845608028654f * (x + 0.044715f * x * x * x); return x_sigmoid(x, 2.0f * u); }
__device__ __forceinline__ float silu_f(float x) { return x_sigmoid(x, x); }
template <int MODE> __device__ __forceinline__ float act_f(float x) { return MODE == 1 ? gelu_tanh(x) : (MODE == 2 ? x * 0.0625f : (MODE == 3 ? silu_f(x) : x)); }
__device__ __forceinline__ f32x4 x_sigmoid_v(f32x4 x, f32x4 t) {
    f32x4 e; e[0] = __builtin_amdgcn_exp2f(t[0]); e[1] = __builtin_amdgcn_exp2f(t[1]); e[2] = __builtin_amdgcn_exp2f(t[2]); e[3] = __builtin_amdgcn_exp2f(t[3]);
    const f32x4 d = e + 1.0f; f32x4 r; r[0] = __builtin_amdgcn_rcpf(d[0]); r[1] = __builtin_amdgcn_rcpf(d[1]); r[2] = __builtin_amdgcn_rcpf(d[2]); r[3] = __builtin_amdgcn_rcpf(d[3]);
    return x * r; }
template <int MODE> __device__ __forceinline__ f32x4 act_v(f32x4 x) {
    if (MODE == 1) { constexpr float K = -2.0f * 0.7978845608028654f * 1.4426950408889634f; return x_sigmoid_v(x, x * ((x * x) * (K * 0.044715f) + K)); }
    if (MODE == 3) return x_sigmoid_v(x, x * -1.4426950408889634f);
    if (MODE == 2) return x * 0.0625f;
    return x; }

struct EpiProj {
    static constexpr bool PERM = true, AFTER_DRAIN = false;
    bf16_t* P; float* glr; float* vst;
    template <int MODE, bool STATS> __device__ __forceinline__ void tile(const f32x4 (&acc)[2][2][4][2], int row0, int col0, int fq) const {
#pragma unroll
        for (int ai = 0; ai < 2; ++ai)
#pragma unroll
            for (int m = 0; m < 4; ++m) { const int row = row0 + ai * HALF + m * 16; bf16_t* rowp = P + (size_t)row * 10240 + col0; float s1 = 0.f, s2 = 0.f;
#pragma unroll
                for (int bj = 0; bj < 2; ++bj) { const f32x4 A0 = act_v<MODE>(acc[ai][bj][m][0]), A1 = act_v<MODE>(acc[ai][bj][m][1]); u32x4 w;
                    if (STATS) { const f32x4 p = A0 + A1, q = A0 * A0 + A1 * A1; s1 += (p[0] + p[1]) + (p[2] + p[3]); s2 += (q[0] + q[1]) + (q[2] + q[3]); }
                    w.x = cvt_pk_bf16(A0[0], A0[1]); w.y = cvt_pk_bf16(A0[2], A0[3]); w.z = cvt_pk_bf16(A1[0], A1[1]); w.w = cvt_pk_bf16(A1[2], A1[3]);
                    *(u32x4*)(rowp + bj * HALF) = w; }
                if (STATS) { s1 += __shfl_xor(s1, 16); s1 += __shfl_xor(s1, 32); s2 += __shfl_xor(s2, 16); s2 += __shfl_xor(s2, 32);
                    if (fq == 0) { atomicAdd(vst + 2 * row, s1); atomicAdd(vst + 2 * row + 1, s2); } } }
    }
    __device__ __forceinline__ void operator()(const f32x4 (&acc)[2][2][4][2], const Unit& u, int wr, int wc, int fr, int fq) const {
        asm volatile("s_nop 15" ::: "memory");
        const int row0 = u.pm * BM + wr * 64 + fr, colt = u.pn * BM;
        if (colt >= 10240) {
            if (wc == 0 && fq < 2) {
#pragma unroll
                for (int ai = 0; ai < 2; ++ai)
#pragma unroll
                    for (int m = 0; m < 4; ++m) { float* rp = glr + (size_t)(row0 + ai * HALF + m * 16) * 16 + 8 * fq; *(f32x4*)rp = acc[ai][0][m][0]; *(f32x4*)(rp + 4) = acc[ai][0][m][1]; }
            }
            return;
        }
        const int col0 = colt + wc * 32 + 8 * fq;
        if (colt < 2048) tile<1, false>(acc, row0, col0, fq); else if (colt < 4096) tile<1, true>(acc, row0, col0, fq); else if (colt < 5120) tile<2, false>(acc, row0, col0, fq);
        else if (colt < 8192) tile<0, false>(acc, row0, col0, fq); else tile<3, false>(acc, row0, col0, fq);
    }
};
struct EpiResidNorm {
    static constexpr bool PERM = true, AFTER_DRAIN = false;
    const float* r0; const float* r1; int split; float* out; bf16_t* hn; const float* gain; float* ssq;
    __device__ __forceinline__ void operator()(const f32x4 (&acc)[2][2][4][2], const Unit& u, int wr, int wc, int fr, int fq) const {
        const int row0 = u.pm * BM + wr * 64 + fr, col0 = u.pn * BM + wc * 32 + 8 * fq;
        const float* rb = (u.pm * BM < split) ? r0 : (r1 - (size_t)split * 4096);
        f32x4 gv[2][2];
#pragma unroll
        for (int bj = 0; bj < 2; ++bj)
#pragma unroll
            for (int n = 0; n < 2; ++n) gv[bj][n] = *(const f32x4*)(gain + col0 + bj * HALF + 4 * n);
#pragma unroll
        for (int ai = 0; ai < 2; ++ai)
#pragma unroll
            for (int m = 0; m < 4; ++m) { const int row = row0 + ai * HALF + m * 16; const size_t off = (size_t)row * 4096 + col0; float s = 0.f;
#pragma unroll
                for (int bj = 0; bj < 2; ++bj) { const f32x4 a0 = *(const f32x4*)(rb + off + bj * HALF) + acc[ai][bj][m][0], a1 = *(const f32x4*)(rb + off + bj * HALF + 4) + acc[ai][bj][m][1];
                    s += ((a0[0] * a0[0] + a0[1] * a0[1]) + (a0[2] * a0[2] + a0[3] * a0[3])) + ((a1[0] * a1[0] + a1[1] * a1[1]) + (a1[2] * a1[2] + a1[3] * a1[3]));
                    const f32x4 y0 = a0 * gv[bj][0], y1 = a1 * gv[bj][1]; u32x4 w; w.x = cvt_pk_bf16(y0[0], y0[1]); w.y = cvt_pk_bf16(y0[2], y0[3]); w.z = cvt_pk_bf16(y1[0], y1[1]); w.w = cvt_pk_bf16(y1[2], y1[3]);
                    *(u32x4*)(hn + off + bj * HALF) = w; }
                s += __shfl_xor(s, 16); s += __shfl_xor(s, 32);
                if (fq == 0) atomicAdd(ssq + row, s);
                asm volatile("" ::: "memory"); }
    }
};
struct EpiResidFinal {
    static constexpr bool PERM = true, AFTER_DRAIN = false;
    bf16_t* x2; const float* gain; float* ssq;
    __device__ __forceinline__ void operator()(const f32x4 (&acc)[2][2][4][2], const Unit& u, int wr, int wc, int fr, int fq) const {
        const int row0 = u.pm * BM + wr * 64 + fr, col0 = u.pn * BM + wc * 32 + 8 * fq;
        f32x4 rg[2][2];
#pragma unroll
        for (int bj = 0; bj < 2; ++bj)
#pragma unroll
            for (int n = 0; n < 2; ++n) { const f32x4 gvv = *(const f32x4*)(gain + col0 + bj * HALF + 4 * n); rg[bj][n][0] = 1.0f / gvv[0]; rg[bj][n][1] = 1.0f / gvv[1]; rg[bj][n][2] = 1.0f / gvv[2]; rg[bj][n][3] = 1.0f / gvv[3]; }
#pragma unroll
        for (int ai = 0; ai < 2; ++ai) {
            u32x4 hw[4][2];
#pragma unroll
            for (int m = 0; m < 4; ++m)
#pragma unroll
                for (int bj = 0; bj < 2; ++bj) hw[m][bj] = *(const u32x4*)(x2 + (size_t)(row0 + ai * HALF + m * 16) * 4096 + col0 + bj * HALF);
#pragma unroll
            for (int m = 0; m < 4; ++m) { const int row = row0 + ai * HALF + m * 16; const size_t off = (size_t)row * 4096 + col0; float s = 0.f;
#pragma unroll
                for (int bj = 0; bj < 2; ++bj) { const u32x4 h = hw[m][bj];
                    f32x4 v0, v1; v0[0] = __builtin_bit_cast(float, h.x << 16); v0[1] = __builtin_bit_cast(float, h.x & 0xffff0000u); v0[2] = __builtin_bit_cast(float, h.y << 16); v0[3] = __builtin_bit_cast(float, h.y & 0xffff0000u);
                    v1[0] = __builtin_bit_cast(float, h.z << 16); v1[1] = __builtin_bit_cast(float, h.z & 0xffff0000u); v1[2] = __builtin_bit_cast(float, h.w << 16); v1[3] = __builtin_bit_cast(float, h.w & 0xffff0000u);
                    v0 = v0 * rg[bj][0] + acc[ai][bj][m][0]; v1 = v1 * rg[bj][1] + acc[ai][bj][m][1];
                    s += ((v0[0] * v0[0] + v0[1] * v0[1]) + (v0[2] * v0[2] + v0[3] * v0[3])) + ((v1[0] * v1[0] + v1[1] * v1[1]) + (v1[2] * v1[2] + v1[3] * v1[3]));
                    u32x4 w; w.x = cvt_pk_bf16(v0[0], v0[1]); w.y = cvt_pk_bf16(v0[2], v0[3]); w.z = cvt_pk_bf16(v1[0], v1[1]); w.w = cvt_pk_bf16(v1[2], v1[3]); *(u32x4*)(x2 + off + bj * HALF) = w; }
                s += __shfl_xor(s, 16); s += __shfl_xor(s, 32);
                if (fq == 0) atomicAdd(ssq + row, s); }
            asm volatile("" ::: "memory"); }
    }
};
struct EpiSwiglu {
    static constexpr bool PERM = true, AFTER_DRAIN = false;
    bf16_t* H; const float* ssq;
    __device__ __forceinline__ void operator()(const f32x4 (&acc)[2][2][4][2], const Unit& u, int wr, int wc, int fr, int fq) const {
        const int row0 = u.pm * BM + wr * 64 + fr, col0 = u.pn * HALF + wc * 32 + 8 * fq;
        float rsv[2][4];
#pragma unroll
        for (int ai = 0; ai < 2; ++ai)
#pragma unroll
            for (int m = 0; m < 4; ++m) rsv[ai][m] = ssq[row0 + ai * HALF + m * 16];
#pragma unroll
        for (int ai = 0; ai < 2; ++ai)
#pragma unroll
            for (int m = 0; m < 4; ++m) rsv[ai][m] = __builtin_amdgcn_rsqf(rsv[ai][m] * (1.f / 4096.f) + 1e-6f);
#pragma unroll
        for (int ai = 0; ai < 2; ++ai)
#pragma unroll
            for (int m = 0; m < 4; ++m) { const int row = row0 + ai * HALF + m * 16; const float rs = rsv[ai][m];
                const float rl = rs * -1.4426950408889634f, rq = rs * rs; u32x4 w;
                const f32x4 o0 = x_sigmoid_v(acc[ai][0][m][0] * acc[ai][1][m][0] * rq, acc[ai][0][m][0] * rl), o1 = x_sigmoid_v(acc[ai][0][m][1] * acc[ai][1][m][1] * rq, acc[ai][0][m][1] * rl);
                w.x = cvt_pk_bf16(o0[0], o0[1]); w.y = cvt_pk_bf16(o0[2], o0[3]); w.z = cvt_pk_bf16(o1[0], o1[1]); w.w = cvt_pk_bf16(o1[2], o1[3]);
                *(u32x4*)(H + (size_t)row * 11008 + col0) = w; }
    }
};

struct EpiPublish {
    static constexpr bool PERM = true, AFTER_DRAIN = false;
    float* slab; unsigned* flags; int nparts;
    __device__ __forceinline__ void operator()(const f32x4 (&acc)[2][2][4][2], const Unit& u, int wr, int wc, int fr, int fq) const {
        asm volatile("s_nop 15" ::: "memory");
        const int wid = wr * 4 + wc, lane = fq * 16 + fr;
        const __amdgpu_buffer_rsrc_t rs = __builtin_amdgcn_make_buffer_rsrc((void*)slab, (short)0, 0x7fffffff, 0x00020000);
        const unsigned off0 = ((unsigned)((u.tt * nparts + u.kp) * 8 + wid) * 16u * 64u + (unsigned)lane) * 16u;
#pragma unroll
        for (int ai = 0; ai < 2; ++ai)
#pragma unroll
            for (int bj = 0; bj < 2; ++bj)
#pragma unroll
                for (int m = 0; m < 4; ++m) { const int q = (ai * 2 + bj) * 4 + m; const f32x4 v0 = acc[ai][bj][m][0], v1 = acc[ai][bj][m][1]; u32x4 w;
                    w.x = cvt_pk_bf16(v0[0], v0[1]); w.y = cvt_pk_bf16(v0[2], v0[3]); w.z = cvt_pk_bf16(v1[0], v1[1]); w.w = cvt_pk_bf16(v1[2], v1[3]);
                    __builtin_amdgcn_raw_buffer_store_b128(w, rs, (int)(off0 + (unsigned)q * 1024u), 0, 16); }
        asm volatile("s_waitcnt vmcnt(0)" ::: "memory");
        if (lane == 0) __hip_atomic_fetch_add(flags + 16 * u.tt, 1u, __ATOMIC_RELAXED, __HIP_MEMORY_SCOPE_AGENT);
    }
};
struct EpiPublishNP : EpiPublish { static constexpr bool PERM = false; };
template <class Base> __device__ __forceinline__ void tail_combine(const TailOrder& TO, const Base& E, const float* slab, unsigned* flags, int nparts) {
    Unit u; if (!TO.next(0, u) || u.kp != 0) return;
    int tid_ = threadIdx.x; asm volatile("" : "+v"(tid_));
    const int wid = __builtin_amdgcn_readfirstlane(tid_ >> 6), lane = tid_ & 63, wr = wid >> 2, wc = wid & 3, fr = lane & 15, fq = lane >> 4;
    { unsigned* flag = flags + 16 * u.tt; const unsigned want = 8u * (unsigned)nparts; unsigned spins = 0;
      while ((unsigned)__builtin_amdgcn_readfirstlane(__hip_atomic_load(flag, __ATOMIC_RELAXED, __HIP_MEMORY_SCOPE_AGENT)) < want) { __builtin_amdgcn_s_sleep(2); if (++spins > (1u << 22)) break; }
      __builtin_amdgcn_fence(__ATOMIC_ACQUIRE, "agent"); asm volatile("s_waitcnt vmcnt(0)" ::: "memory"); }
    f32x4 acc[2][2][4][2];
#pragma unroll
    for (int ai = 0; ai < 2; ++ai)
#pragma unroll
        for (int bj = 0; bj < 2; ++bj)
#pragma unroll
            for (int m = 0; m < 4; ++m)
#pragma unroll
                for (int n = 0; n < 2; ++n) acc[ai][bj][m][n] = (f32x4){0.f, 0.f, 0.f, 0.f};
    for (int p = 0; p < nparts; ++p) {
        const u32x4* src = (const u32x4*)slab + ((size_t)((u.tt * nparts + p) * 8 + wid) * 16) * 64 + lane;
#pragma unroll
        for (int ai = 0; ai < 2; ++ai)
#pragma unroll
            for (int bj = 0; bj < 2; ++bj) {
#pragma unroll
                for (int m = 0; m < 4; ++m) { const int q = (ai * 2 + bj) * 4 + m; const u32x4 w = src[(size_t)q * 64]; f32x4 v0, v1;
                    v0[0] = __builtin_bit_cast(float, w.x << 16); v0[1] = __builtin_bit_cast(float, w.x & 0xffff0000u); v0[2] = __builtin_bit_cast(float, w.y << 16); v0[3] = __builtin_bit_cast(float, w.y & 0xffff0000u);
                    v1[0] = __builtin_bit_cast(float, w.z << 16); v1[1] = __builtin_bit_cast(float, w.z & 0xffff0000u); v1[2] = __builtin_bit_cast(float, w.w << 16); v1[3] = __builtin_bit_cast(float, w.w & 0xffff0000u);
                    acc[ai][bj][m][0] += v0; acc[ai][bj][m][1] += v1; }
                asm volatile("" ::: "memory"); }
    }
    E(acc, u, wr, wc, fr, fq);
}
template <class Epi, class Sched, bool ALIGN_EPI = false, bool SP2 = false>
__device__ __forceinline__ void gemm_phase(PG8_LAS unsigned char* lds, const Gemm g, const Sched& S, const Epi& E) {
    int tid_ = threadIdx.x; asm volatile("" : "+v"(tid_));
    const int tid = tid_, wid = __builtin_amdgcn_readfirstlane(tid >> 6), lane = tid & 63, wr = wid >> 2, wc = wid & 3, fr = lane & 15, fq = lane >> 4;
    const int K = g.K, nt = K / BK, LD = g.ld ? g.ld : g.K;
    unsigned voffA[2], voffB[2];
#pragma unroll
    for (int i = 0; i < 2; ++i) { int R, C; stage_rc(tid * 16 + i * 8192, R, C); const int Rb = Epi::PERM ? ((R & ~31) + perm32(R & 31)) : R;
        voffA[i] = (unsigned)(R * LD + C) * 2u; voffB[i] = (unsigned)(Rb * LD + C) * 2u; }
    const size_t kstep = (size_t)(BK * 2);
    const size_t hstep = (size_t)HALF * LD * 2;
    const size_t tstep = 2 * hstep;
    const unsigned ldsw = (unsigned)wid * 1024u;
    const int aoff = lds_byte(wr * 64 + fr, fq * 8), boff = lds_byte(wc * 32 + fr, fq * 8);
#define PG8_SA(b, h) (((b) * 2 + (h)) * HTB)
#define PG8_SB(b, h) ((4 + (b) * 2 + (h)) * HTB)
#define PG8_STAGE(bufoff, gbase, voff) do { _Pragma("unroll") for (int _i = 0; _i < 2; ++_i) \
        __builtin_amdgcn_global_load_lds((const unsigned*)((const char*)(gbase) + (voff)[_i]), (PG8_LAS unsigned*)(lds + (bufoff) + ldsw + _i * 8192), 16, 0, 0); } while (0)
#define PG8_LDA(dst, b, h) do { _Pragma("unroll") for (int m = 0; m < 4; ++m) _Pragma("unroll") for (int k = 0; k < 2; ++k) dst[m][k] = *(const PG8_LAS bf16x8*)(lds + PG8_SA(b, h) + aoff + m * 2048 + k * 1024); } while (0)
#define PG8_LDB(dst, b, h) do { _Pragma("unroll") for (int n = 0; n < 2; ++n) _Pragma("unroll") for (int k = 0; k < 2; ++k) dst[n][k] = *(const PG8_LAS bf16x8*)(lds + PG8_SB(b, h) + boff + n * 2048 + k * 1024); } while (0)
#define PG8_MMA(ai, bj, At, Bt) do { __builtin_amdgcn_s_setprio(1); _Pragma("unroll") for (int m = 0; m < 4; ++m) _Pragma("unroll") for (int n = 0; n < 2; ++n) _Pragma("unroll") for (int k = 0; k < 2; ++k) \
        acc[ai][bj][m][n] = __builtin_amdgcn_mfma_f32_16x16x32_bf16(Bt[n][k], At[m][k], acc[ai][bj][m][n], 0, 0, 0); __builtin_amdgcn_s_setprio(0); } while (0)
#define PG8_WAIT_V(n) asm volatile("s_waitcnt vmcnt(" #n ")" ::: "memory")
#define PG8_WAIT_L(n) asm volatile("s_waitcnt lgkmcnt(" #n ")" ::: "memory")
#define PG8_BAR __builtin_amdgcn_s_barrier()
#define PG8_SCHED __builtin_amdgcn_sched_barrier(0)
    Unit cur, nxt; int ui = 0;
    if (!S.next(0, cur)) return;
    f32x4 acc[2][2][4][2];
#pragma unroll
    for (int a = 0; a < 2; ++a)
#pragma unroll
        for (int b = 0; b < 2; ++b)
#pragma unroll
            for (int m = 0; m < 4; ++m)
#pragma unroll
                for (int n = 0; n < 2; ++n) acc[a][b][m][n] = (f32x4){0.f, 0.f, 0.f, 0.f};
    bf16x8 At[4][2], B0[2][2], B1[2][2];
    const char* cA = (const char*)g.A + (size_t)cur.pm * tstep + (size_t)cur.kp * K * 2; const char* cB = (const char*)g.Bt + (size_t)cur.pn * tstep + (size_t)cur.kp * K * 2;
    S.a_ready(cur);
    if constexpr (SP2) {
        PG8_STAGE(PG8_SB(0, 0), cB, voffB); PG8_STAGE(PG8_SB(0, 1), cB + hstep, voffB); PG8_STAGE(PG8_SA(0, 0), cA, voffA); PG8_STAGE(PG8_SA(0, 1), cA + hstep, voffA);
        if (wr == 1) PG8_BAR;
        PG8_WAIT_V(2); PG8_BAR;
        PG8_STAGE(PG8_SB(1, 0), cB + kstep, voffB); PG8_STAGE(PG8_SA(1, 0), cA + kstep, voffA); PG8_STAGE(PG8_SB(1, 1), cB + hstep + kstep, voffB);
        PG8_WAIT_V(6); PG8_BAR;
    } else {
        PG8_STAGE(PG8_SB(0, 0), cB, voffB); PG8_STAGE(PG8_SA(0, 0), cA, voffA); PG8_STAGE(PG8_SB(0, 1), cB + hstep, voffB); PG8_STAGE(PG8_SA(0, 1), cA + hstep, voffA);
        if (wr == 1) PG8_BAR;
        PG8_WAIT_V(4); PG8_BAR;
        PG8_STAGE(PG8_SB(1, 0), cB + kstep, voffB); PG8_STAGE(PG8_SA(1, 0), cA + kstep, voffA); PG8_STAGE(PG8_SB(1, 1), cB + hstep + kstep, voffB);
        PG8_WAIT_V(6); PG8_BAR;
    }
    for (;;) {
        const bool has_next = S.next(ui + 1, nxt);
        const char* nA = has_next ? (const char*)g.A + (size_t)nxt.pm * tstep + (size_t)nxt.kp * K * 2 : cA; const char* nB = has_next ? (const char*)g.Bt + (size_t)nxt.pn * tstep + (size_t)nxt.kp * K * 2 : cB;
        for (int t = 0; t < nt; t += 2) {
            const bool last = (t == nt - 2);
            const char* a1 = cA + (size_t)(t + 1) * kstep;
            const char* a2 = last ? nA : cA + (size_t)(t + 2) * kstep; const char* b2 = last ? nB : cB + (size_t)(t + 2) * kstep;
            const char* a3 = a2 + kstep; const char* b3 = b2 + kstep;
            if (last && has_next) S.a_ready(nxt);
            if constexpr (SP2) {
            PG8_LDB(B0, 0, 0); PG8_LDB(B1, 0, 1); PG8_SCHED; PG8_LDA(At, 0, 0); PG8_STAGE(PG8_SA(1, 1), a1 + hstep, voffA);
            PG8_WAIT_V(8); PG8_WAIT_L(0); PG8_BAR; PG8_MMA(0, 0, At, B0); PG8_MMA(0, 1, At, B1); PG8_BAR; PG8_SCHED;
            PG8_LDA(At, 0, 1); PG8_STAGE(PG8_SB(0, 0), b2, voffB); PG8_STAGE(PG8_SB(0, 1), b2 + hstep, voffB); PG8_STAGE(PG8_SA(0, 0), a2, voffA);
            PG8_WAIT_V(8); PG8_WAIT_L(0); PG8_BAR; PG8_MMA(1, 0, At, B0); PG8_MMA(1, 1, At, B1); PG8_BAR; PG8_SCHED;
            PG8_LDB(B0, 1, 0); PG8_LDB(B1, 1, 1); PG8_SCHED; PG8_LDA(At, 1, 0); PG8_STAGE(PG8_SA(0, 1), a2 + hstep, voffA);
            PG8_WAIT_V(8); PG8_WAIT_L(0); PG8_BAR; PG8_MMA(0, 0, At, B0); PG8_MMA(0, 1, At, B1); PG8_BAR; PG8_SCHED;
            PG8_LDA(At, 1, 1); PG8_STAGE(PG8_SB(1, 0), b3, voffB); PG8_STAGE(PG8_SB(1, 1), b3 + hstep, voffB); PG8_STAGE(PG8_SA(1, 0), a3, voffA);
            PG8_WAIT_V(8); PG8_WAIT_L(0); PG8_BAR; PG8_MMA(1, 0, At, B0); PG8_MMA(1, 1, At, B1); PG8_BAR; PG8_SCHED;
            } else {
            PG8_LDB(B0, 0, 0); PG8_SCHED; PG8_LDA(At, 0, 0); PG8_STAGE(PG8_SA(1, 1), a1 + hstep, voffA);
            PG8_WAIT_L(8); PG8_BAR; PG8_WAIT_L(0); PG8_MMA(0, 0, At, B0); PG8_BAR; PG8_SCHED;
            PG8_LDB(B1, 0, 1); PG8_STAGE(PG8_SB(0, 0), b2, voffB);
            PG8_BAR; PG8_WAIT_L(0); PG8_MMA(0, 1, At, B1); PG8_BAR;
            PG8_LDA(At, 0, 1); PG8_STAGE(PG8_SA(0, 0), a2, voffA);
            PG8_BAR; PG8_WAIT_L(0); PG8_MMA(1, 0, At, B0); PG8_BAR; PG8_SCHED;
            PG8_STAGE(PG8_SB(0, 1), b2 + hstep, voffB);
            PG8_WAIT_V(6); PG8_BAR; PG8_MMA(1, 1, At, B1); PG8_BAR;
            PG8_LDB(B0, 1, 0); PG8_SCHED; PG8_LDA(At, 1, 0); PG8_STAGE(PG8_SA(0, 1), a2 + hstep, voffA);
            PG8_WAIT_L(8); PG8_BAR; PG8_WAIT_L(0); PG8_MMA(0, 0, At, B0); PG8_BAR; PG8_SCHED;
            PG8_LDB(B1, 1, 1); PG8_STAGE(PG8_SB(1, 0), b3, voffB);
            PG8_BAR; PG8_WAIT_L(0); PG8_MMA(0, 1, At, B1); PG8_BAR;
            PG8_LDA(At, 1, 1); PG8_STAGE(PG8_SA(1, 0), a3, voffA);
            PG8_BAR; PG8_WAIT_L(0); PG8_MMA(1, 0, At, B0); PG8_BAR; PG8_SCHED;
            PG8_STAGE(PG8_SB(1, 1), b3 + hstep, voffB);
            PG8_WAIT_V(6); PG8_BAR; PG8_MMA(1, 1, At, B1); PG8_BAR;
            }
        }
        if constexpr (ALIGN_EPI) { if (wr == 0) PG8_BAR; }
        if constexpr (!Epi::AFTER_DRAIN) { E(acc, cur, wr, wc, fr, fq); S.done(cur); }
        if (!has_next) break;
#pragma unroll
        for (int a = 0; a < 2; ++a)
#pragma unroll
            for (int b = 0; b < 2; ++b)
#pragma unroll
                for (int m = 0; m < 4; ++m)
#pragma unroll
                    for (int n = 0; n < 2; ++n) acc[a][b][m][n] = (f32x4){0.f, 0.f, 0.f, 0.f};
        cur = nxt; cA = nA; cB = nB; ++ui;
        if constexpr (ALIGN_EPI) { if (wr == 1) PG8_BAR; }
    }
    PG8_WAIT_V(0);
    if constexpr (!ALIGN_EPI) { if (wr == 0) PG8_BAR; }
    PG8_BAR;
    if constexpr (Epi::AFTER_DRAIN) { E.fused(acc, cur, wr, wc, fr, fq, lds, wid, lane); S.done(cur); }
#undef PG8_SA
#undef PG8_SB
#undef PG8_STAGE
#undef PG8_LDA
#undef PG8_LDB
#undef PG8_MMA
#undef PG8_WAIT_V
#undef PG8_WAIT_L
#undef PG8_BAR
#undef PG8_SCHED
}
}

constexpr int NWAVES = 8;
constexpr int DM = 4096, MP = 16384, MS = 2048, M = MP + MS;
constexpr int AWID = 2048, AHD = 128, HK = 256, HV = 512, NHB = 4, DFF = 11008;
constexpr int INC = 10256, NPROJ = 10240, NPAD = 10496;
constexpr int C_U = 0, C_V = 2048, C_Q = 4096, C_K = 5120, C_VV = 6144, C_R = 8192;
constexpr int NBLK = M / 64, NBH = NBLK * NHB;
constexpr int NG = 8, GB = 32;
constexpr float EPS = 1e-6f;
constexpr size_t O_Y = 0, O_GP = (size_t)M * DM, O_GS = O_GP + (size_t)NHB * HK * HV, O_SV = O_GS + (size_t)32 * NHB * HK * HV, O_END = O_SV + (size_t)MS * AWID;
static_assert(O_END == 96993280, "output size");

constexpr size_t WS_CTL = 0, CTL_ZERO_BYTES = 1u << 20;
constexpr size_t WS_WIN = CTL_ZERO_BYTES;
constexpr size_t WS_WOUT = WS_WIN + (size_t)NPAD * DM * 2;
constexpr size_t WS_WGU = WS_WOUT + (size_t)DM * DM * 2;
constexpr size_t WS_WDN = WS_WGU + (size_t)2 * DFF * DM * 2;
constexpr size_t WS_HN = WS_WDN + (size_t)DM * DFF * 2;
constexpr size_t WS_PROJ = WS_HN + (size_t)M * DM * 2;
constexpr size_t WS_MIX = WS_PROJ + (size_t)M * NPROJ * 2;
constexpr size_t WS_QE = WS_MIX + (size_t)M * DM * 2;
constexpr size_t WS_GLR = WS_QE + (size_t)M * 1024 * 2;
constexpr size_t WS_STATS = WS_GLR + (size_t)M * 16 * 4;
constexpr size_t WS_BLAST = WS_STATS + (size_t)M * 2 * 4;
constexpr size_t WS_LST = WS_BLAST + (size_t)NBH * HK * 4;
constexpr size_t WS_GDEC = WS_LST + (size_t)NG * NHB * HK * HV * 4;
constexpr size_t WS_END = WS_GDEC + (size_t)NG * NHB * HK * 4;
constexpr size_t WS_KLT = WS_HN;
constexpr size_t WS_ATT = WS_KLT + (size_t)NBH * HK * 64 * 2;
constexpr size_t WS_VT = WS_ATT + (size_t)NBH * 64 * 64 * 2;
static_assert(WS_VT + (size_t)NBH * HV * 64 * 2 <= WS_PROJ, "GLA block operands overlay HN");
constexpr size_t WS_O = WS_WIN;
static_assert((size_t)M * 2048 * 2 <= (size_t)NPAD * DM * 2, "O overlays WIN");
constexpr size_t WS_SLAB = WS_WIN;
static_assert((size_t)144 * 262144 <= (size_t)NPAD * DM * 2, "slabs overlay WIN");
constexpr size_t WS_HFF = WS_PROJ;
static_assert(WS_HFF + (size_t)M * DFF * 2 <= WS_QE, "HFF overlays PROJ|MIX");
static_assert(WS_END <= 1146501120ull, "workspace budget = sum of the inputs");
constexpr int CW_BAR = 4096;
constexpr int CW_SSQ = 32768;
constexpr int CW_SSQ2 = 65536;
constexpr int CW_VST = 131072;
constexpr int CW_FLAG = 98304;
constexpr int CW_XRANK = 12288;

constexpr int RING_BYTES = 131072, PHASE_LDS = 139264, MISC_OFF = PHASE_LDS + 320, LDS_BYTES = 147456;

#define GAS __attribute__((address_space(1)))
#define LAS __attribute__((address_space(3)))
typedef unsigned short bf16;
typedef unsigned v4u __attribute__((ext_vector_type(4)));
typedef unsigned v2u __attribute__((ext_vector_type(2)));
typedef float f32x4 __attribute__((ext_vector_type(4)));
typedef short bf16x8 __attribute__((ext_vector_type(8)));
#define LDS_WAIT() asm volatile("s_waitcnt lgkmcnt(0)" ::: "memory")
#define LDS_BARRIER() asm volatile("s_waitcnt lgkmcnt(0)\n\ts_barrier" ::: "memory")
#define MFMA16(a, b, c) __builtin_amdgcn_mfma_f32_16x16x32_bf16((a), (b), (c), 0, 0, 0)
__device__ __forceinline__ unsigned f2bf(float f) { unsigned u = __builtin_bit_cast(unsigned, f); return (u + 0x7fffu + ((u >> 16) & 1u)) >> 16; }
__device__ __forceinline__ unsigned pk2(float lo, float hi) { return f2bf(lo) | (f2bf(hi) << 16); }
__device__ __forceinline__ unsigned pk2hw(float lo, float hi) { unsigned r; asm("v_cvt_pk_bf16_f32 %0, %1, %2" : "=v"(r) : "v"(lo), "v"(hi)); return r; }
__device__ __forceinline__ float bflo(unsigned w) { return __builtin_bit_cast(float, w << 16); }
__device__ __forceinline__ float bfhi(unsigned w) { return __builtin_bit_cast(float, w & 0xffff0000u); }
__device__ __forceinline__ float bf2f(bf16 b) { return __builtin_bit_cast(float, (unsigned)b << 16); }

#define XB_TMO      128
#define XB_XCNT(j)  (256  + 64 * (j))
#define XB_XSUB(j)  (1280 + 64 * (j))
#define XB_XGEN(j)  (2304 + 64 * (j))
#define XB_TOP      3328
#define XB_TOPGEN   3392
#define XCD_BAR_WORDS 3456
#define XB_SPIN_CAP (1u << 18)

__device__ __forceinline__ unsigned xb_ld(unsigned* p)              { return __hip_atomic_load(p, __ATOMIC_RELAXED, __HIP_MEMORY_SCOPE_AGENT); }
__device__ __forceinline__ unsigned xb_add(unsigned* p, unsigned v) { return __hip_atomic_fetch_add(p, v, __ATOMIC_RELAXED, __HIP_MEMORY_SCOPE_AGENT); }
__device__ __forceinline__ unsigned xb_xcc_id() { return (unsigned)__builtin_amdgcn_s_getreg((3 << 11) | 20) & 0xFu; }
#define XB_SPIN(cond, bar) do { unsigned _sp = 0; while (cond) { __builtin_amdgcn_s_sleep(1); \
    if ((++_sp & 255u) == 0u) { if (xb_ld(&(bar)[XB_TMO])) break; if (_sp > XB_SPIN_CAP) { atomicAdd(&(bar)[XB_TMO], 1u); break; } } } } while (0)

struct XcdBarrier {
    unsigned* bar; unsigned x;
    volatile LAS unsigned* st;
};

__device__ __forceinline__ XcdBarrier xcd_barrier_post(unsigned* bar, volatile LAS unsigned* st) {
    XcdBarrier b; b.bar = bar; b.x = xb_xcc_id(); b.st = st;
    if (threadIdx.x == 0) (void)xb_add(&bar[XB_XCNT(b.x)], 1u);
    return b;
}
__device__ __forceinline__ void xcd_barrier_complete(unsigned* bar, unsigned x, unsigned& nloc, unsigned& nx) {
    const unsigned G = gridDim.x * gridDim.y * gridDim.z;
    unsigned sum, cnt, mine, sp = 0u;
    for (;;) {
        sum = 0u; cnt = 0u; mine = 0u;
#pragma unroll
        for (unsigned j = 0; j < 16; ++j) { const unsigned c = xb_ld(&bar[XB_XCNT(j)]); sum += c; cnt += (c > 0u) ? 1u : 0u; mine = (j == x) ? c : mine; }
        if (sum == G) break;
        __builtin_amdgcn_s_sleep(1);
        if ((++sp & 255u) == 0u) { if (xb_ld(&bar[XB_TMO])) break; if (sp > XB_SPIN_CAP) { atomicAdd(&bar[XB_TMO], 1u); break; } }
    }
    nloc = mine > 0u ? mine : 1u; nx = cnt > 0u ? cnt : 1u;
}

__device__ __forceinline__ void xcd_barrier(const XcdBarrier& b) {
    asm volatile("s_waitcnt vmcnt(0)" ::: "memory");
    __syncthreads();
    if (threadIdx.x == 0) {
        unsigned* bar = b.bar;
        __builtin_amdgcn_s_waitcnt(0);
        unsigned nloc = b.st[0], nx = b.st[1];
        if (nloc == 0u) { xcd_barrier_complete(bar, b.x, nloc, nx); b.st[0] = nloc; b.st[1] = nx; }
        const unsigned old = xb_add(&bar[XB_XSUB(b.x)], 1u);
        const unsigned gen = old / nloc;
        if (old + 1u == (gen + 1u) * nloc) {
            __builtin_amdgcn_fence(__ATOMIC_RELEASE, "agent");
            asm volatile("s_waitcnt vmcnt(0)" ::: "memory");
            const unsigned og = xb_add(&bar[XB_TOP], 1u);
            const unsigned tg = og / nx;
            if (og + 1u == (tg + 1u) * nx) xb_add(&bar[XB_TOPGEN], 1u);
            else XB_SPIN(xb_ld(&bar[XB_TOPGEN]) == tg, bar);
            __builtin_amdgcn_fence(__ATOMIC_ACQUIRE, "agent");
            xb_add(&bar[XB_XGEN(b.x)], 1u);
            asm volatile("s_waitcnt vmcnt(0)" ::: "memory");
        } else {
            XB_SPIN(xb_ld(&bar[XB_XGEN(b.x)]) == gen, bar);
            __builtin_amdgcn_fence(__ATOMIC_ACQUIRE, "agent");
            asm volatile("s_waitcnt vmcnt(0)" ::: "memory");
        }
    }
    __syncthreads();
}
struct Frame {
    LAS unsigned char* lds;
    unsigned* ctl;
    int tid, lane, wave, G, wg, wgv;
    const float *x_prompt, *x_sample, *state_gla, *g_mix, *w_in, *w_s, *b_s, *ln_g, *ln_b, *w_gate_up, *b_gate, *gla_norm_g, *w_out, *g_ffn, *w_ffn_gate, *w_ffn_up, *w_ffn_down, *g_final;
    float* out;
    bf16 *WIN, *WOUT, *WGU, *WDN, *HN, *PROJ, *MIX, *QE, *KLT, *ATT, *VT, *O, *HFF;
    float *GLR, *STATS, *BLAST, *LST, *GDEC;
};
__device__ __forceinline__ const float* x_row(const Frame& F, int m) { return m < MP ? F.x_prompt + (size_t)m * DM : F.x_sample + (size_t)(m - MP) * DM; }
__device__ __forceinline__ float wave_sum(float v) {
#pragma unroll
    for (int o = 1; o < 64; o <<= 1) v += __shfl_xor(v, o);
    return v;
}

__device__ __forceinline__ void transpose_item(const float* W, int ldw, int K, int k0, int n0, int nvalid, bf16* WTrow0, LAS float* scr, int lane) {
    const float* src = W + (size_t)k0 * ldw + n0 + lane; const bool ok = lane < nvalid;
    float v[64];
#pragma unroll
    for (int kk = 0; kk < 64; ++kk) v[kk] = ok ? src[(size_t)kk * ldw] : 0.f;
#pragma unroll
    for (int kk = 0; kk < 64; ++kk) scr[kk * 65 + lane] = v[kk];
    LDS_WAIT(); asm volatile("" ::: "memory");
    const int c8 = lane & 7;
#pragma unroll
    for (int j = 0; j < 8; ++j) { const int n = (lane >> 3) + 8 * j; const LAS float* s = scr + (8 * c8) * 65 + n;
        v4u o; o.x = pk2hw(s[0 * 65], s[1 * 65]); o.y = pk2hw(s[2 * 65], s[3 * 65]); o.z = pk2hw(s[4 * 65], s[5 * 65]); o.w = pk2hw(s[6 * 65], s[7 * 65]);
        if (n < nvalid || nvalid >= 32) *(GAS v4u*)(WTrow0 + (size_t)n * K + k0 + 8 * c8) = o; }
    LDS_WAIT(); asm volatile("" ::: "memory");
}
struct RowGain { f32x4 g0[8], g1[8]; };
__device__ __forceinline__ void row_gain_load(const float* gain, int lane, RowGain& G) {
    const GAS f32x4* gr = (const GAS f32x4*)gain + 2 * lane;
#pragma unroll
    for (int j = 0; j < 8; ++j) { G.g0[j] = gr[128 * j]; G.g1[j] = gr[128 * j + 1]; }
}
__device__ __forceinline__ void rms_row_to_bf16(const float* xrow, const RowGain& G, bf16* orow, int lane) {
    const GAS f32x4* xr = (const GAS f32x4*)xrow + 2 * lane;
    f32x4 v[8][2]; float s = 0.f;
#pragma unroll
    for (int j = 0; j < 8; ++j) { v[j][0] = xr[128 * j]; v[j][1] = xr[128 * j + 1];
        s += ((v[j][0].x * v[j][0].x + v[j][0].y * v[j][0].y) + (v[j][0].z * v[j][0].z + v[j][0].w * v[j][0].w)) + ((v[j][1].x * v[j][1].x + v[j][1].y * v[j][1].y) + (v[j][1].z * v[j][1].z + v[j][1].w * v[j][1].w)); }
    const float rstd = 1.0f / sqrtf(wave_sum(s) * (1.f / DM) + EPS);
    GAS v4u* o16 = (GAS v4u*)orow + lane;
#pragma unroll
    for (int j = 0; j < 8; ++j) { const f32x4 g0 = G.g0[j], g1 = G.g1[j]; v4u w;
        w.x = pk2hw(v[j][0].x * rstd * g0.x, v[j][0].y * rstd * g0.y); w.y = pk2hw(v[j][0].z * rstd * g0.z, v[j][0].w * rstd * g0.w);
        w.z = pk2hw(v[j][1].x * rstd * g1.x, v[j][1].y * rstd * g1.y); w.w = pk2hw(v[j][1].z * rstd * g1.z, v[j][1].w * rstd * g1.w); o16[64 * j] = w; }
}
constexpr int P0_NB_IN = (INC + 63) / 64;
constexpr int P0_I_IN = 64 * P0_NB_IN, P0_I_OUT = 64 * 64, P0_I_G = 64 * (DFF / 64), P0_I_D = (DFF / 64) * 64, P0_NITEMS = P0_I_IN + P0_I_OUT + 2 * P0_I_G + P0_I_D;
#ifndef P0_MOVED
#define P0_MOVED 1536
#endif
__device__ __forceinline__ void convert_items(Frame& F, int it0, int it1, int gw, int nw) {
    int lane_ = F.lane, wave_ = F.wave; asm volatile("" : "+v"(lane_), "+s"(wave_));
    LAS float* scr = (LAS float*)(F.lds + wave_ * 16640);
    for (int it = it0 + gw; it < it1; it += nw) {
        int r = it;
        if (r < P0_I_OUT) { const int kb = r / 64, nb = r % 64, n0 = 64 * nb; transpose_item(F.w_out, DM, DM, 64 * kb, n0, 64, F.WOUT + (size_t)n0 * DM, scr, lane_); continue; } r -= P0_I_OUT;
        if (r < 2 * P0_I_G) { const int up = r >= P0_I_G; if (up) r -= P0_I_G; const int nbn = DFF / 64, kb = r / nbn, nb = r % nbn, n0 = 64 * nb;
            const int row0 = (n0 / 128) * 256 + up * 128 + (n0 % 128);
            transpose_item(up ? F.w_ffn_up : F.w_ffn_gate, DFF, DM, 64 * kb, n0, 64, F.WGU + (size_t)row0 * DM, scr, lane_); continue; } r -= 2 * P0_I_G;
        if (r < P0_I_D) { const int kb = r / 64, nb = r % 64, n0 = 64 * nb; transpose_item(F.w_ffn_down, DM, DFF, 64 * kb, n0, 64, F.WDN + (size_t)n0 * DFF, scr, lane_); continue; } r -= P0_I_D;
        { const int kb = r / P0_NB_IN, nb = r % P0_NB_IN, n0 = 64 * nb; transpose_item(F.w_in, INC, DM, 64 * kb, n0, INC - n0 >= 64 ? 64 : INC - n0, F.WIN + (size_t)n0 * DM, scr, lane_); }
    }
}
struct CvtItem { const float* src; bf16* dst; int ldw, K, k0; };
__device__ __forceinline__ CvtItem cvt_decode(const Frame& F, int it) {
    int r = it - P0_I_OUT; CvtItem c;
    if (r < 2 * P0_I_G) { const int up = r >= P0_I_G; if (up) r -= P0_I_G; const int nbn = DFF / 64, kb = r / nbn, nb = r % nbn, n0 = 64 * nb, row0 = (n0 / 128) * 256 + up * 128 + (n0 % 128);
        c.src = (up ? F.w_ffn_up : F.w_ffn_gate) + (size_t)(64 * kb) * DFF + n0; c.dst = F.WGU + (size_t)row0 * DM; c.ldw = DFF; c.K = DM; c.k0 = 64 * kb; return c; }
    r -= 2 * P0_I_G; { const int kb = r / 64, nb = r % 64, n0 = 64 * nb; c.src = F.w_ffn_down + (size_t)(64 * kb) * DM + n0; c.dst = F.WDN + (size_t)n0 * DFF; c.ldw = DM; c.K = DFF; c.k0 = 64 * kb; return c; }
}
__device__ __forceinline__ void cvt_load(const CvtItem& c, int lane, float (&v)[64]) {
    const float* s = c.src + lane;
#pragma unroll
    for (int kk = 0; kk < 64; ++kk) v[kk] = s[(size_t)kk * c.ldw];
}
__device__ __forceinline__ void cvt_store(const CvtItem& c, int lane, const float (&v)[64], LAS float* scr) {
#pragma unroll
    for (int kk = 0; kk < 64; ++kk) scr[kk * 65 + lane] = v[kk];
    LDS_WAIT(); asm volatile("" ::: "memory");
    const int c8 = lane & 7;
#pragma unroll
    for (int j = 0; j < 8; ++j) { const int n = (lane >> 3) + 8 * j; const LAS float* s = scr + (8 * c8) * 65 + n;
        v4u o; o.x = pk2hw(s[0 * 65], s[1 * 65]); o.y = pk2hw(s[2 * 65], s[3 * 65]); o.z = pk2hw(s[4 * 65], s[5 * 65]); o.w = pk2hw(s[6 * 65], s[7 * 65]);
        *(GAS v4u*)(c.dst + (size_t)n * c.K + c.k0 + 8 * c8) = o; }
    LDS_WAIT(); asm volatile("" ::: "memory");
}
__device__ __forceinline__ void convert_items_pipelined(Frame& F, int it0, int it1, int gw, int nw) {
    int lane_ = F.lane, wave_ = F.wave; asm volatile("" : "+v"(lane_), "+s"(wave_));
    LAS float* scr = (LAS float*)(F.lds + wave_ * 16640);
    int it = it0 + gw; if (it >= it1) return;
    float va[64], vb[64]; CvtItem ca = cvt_decode(F, it), cb = ca; cvt_load(ca, lane_, va);
    for (;;) {
        const int i1 = it + nw; const bool h1 = i1 < it1; if (h1) { cb = cvt_decode(F, i1); cvt_load(cb, lane_, vb); }
        cvt_store(ca, lane_, va, scr);
        if (!h1) break;
        const int i2 = i1 + nw; const bool h2 = i2 < it1; if (h2) { ca = cvt_decode(F, i2); cvt_load(ca, lane_, va); }
        cvt_store(cb, lane_, vb, scr);
        if (!h2) break;
        it = i2;
    }
}
#ifndef P1_DED
#define P1_DED 12288
#endif
__device__ __forceinline__ void p0_prologue(Frame& F) {
    const int gw = F.wg * NWAVES + F.wave, NGW = F.G * NWAVES;
    constexpr int FFN_END = P0_I_OUT + 2 * P0_I_G + P0_I_D;
#pragma unroll
    for (int rp = 0; rp < 1; ++rp) { convert_items(F, 0, FFN_END - P0_MOVED - (F.G == 256 ? P1_DED : 0), gw, NGW); convert_items(F, FFN_END, P0_NITEMS, gw, NGW); }
#pragma unroll
    for (int rp = 0; rp < 1; ++rp) { RowGain RG; row_gain_load(F.g_mix, F.lane, RG); for (int m = gw; m < M; m += NGW) rms_row_to_bf16(x_row(F, m), RG, F.HN + (size_t)m * DM, F.lane); }
}

__device__ __forceinline__ void ln_mean_rstd(const Frame& F, int m, float& mean, float& rstd) {
    const float s1 = ((const float*)(F.ctl + CW_VST))[2 * m], s2 = ((const float*)(F.ctl + CW_VST))[2 * m + 1];
    mean = s1 * (1.f / AWID); rstd = 1.0f / sqrtf(fmaxf(s2 * (1.f / AWID) - mean * mean, 0.f) + EPS);
}
__device__ __forceinline__ void ln_sample_row(Frame& F, int m) {
    const GAS v4u* vr = (const GAS v4u*)(F.PROJ + (size_t)m * NPROJ + C_V) + F.lane;
    float mean, rstd; ln_mean_rstd(F, m, mean, rstd);
    float* o = F.out + O_SV + (size_t)(m - MP) * AWID;
#pragma unroll
    for (int i = 0; i < 4; ++i) { const v4u w = vr[64 * i]; const int c = 8 * (F.lane + 64 * i);
        const float f[8] = {bflo(w.x), bfhi(w.x), bflo(w.y), bfhi(w.y), bflo(w.z), bfhi(w.z), bflo(w.w), bfhi(w.w)};
        const f32x4 g0 = *(const f32x4*)(F.ln_g + c), g1 = *(const f32x4*)(F.ln_g + c + 4), b0 = *(const f32x4*)(F.ln_b + c), b1 = *(const f32x4*)(F.ln_b + c + 4);
        f32x4 o0, o1;
        o0.x = (f[0] - mean) * rstd * g0.x + b0.x; o0.y = (f[1] - mean) * rstd * g0.y + b0.y; o0.z = (f[2] - mean) * rstd * g0.z + b0.z; o0.w = (f[3] - mean) * rstd * g0.w + b0.w;
        o1.x = (f[4] - mean) * rstd * g1.x + b1.x; o1.y = (f[5] - mean) * rstd * g1.y + b1.y; o1.z = (f[6] - mean) * rstd * g1.z + b1.z; o1.w = (f[7] - mean) * rstd * g1.w + b1.w;
        *(f32x4*)(o + c) = o0; *(f32x4*)(o + c + 4) = o1; }
}
__device__ __forceinline__ float log_sigmoid_f(float z) { return fminf(z, 0.f) - __logf(1.0f + __expf(-fabsf(z))); }
constexpr int PREP_GLR = 0, PREP_TOT = 4096, PREP_BREF = 5120, PREP_BLAST = 6144, PREP_QD = 8192, PREP_PITCH = 264, PREP_KD = PREP_QD + 64 * PREP_PITCH * 2, PREP_END = PREP_KD + 64 * PREP_PITCH * 2;
static_assert(PREP_END <= RING_BYTES, "prep LDS");
__device__ __forceinline__ void gla_prep_unit(Frame& F, int bh) {
    const int blk = bh >> 2, h = bh & 3, m0 = 64 * blk, kd = F.tid & 255, half = F.tid >> 8;
    LAS float* glr_l = (LAS float*)(F.lds + PREP_GLR); LAS float* tot = (LAS float*)(F.lds + PREP_TOT); LAS float* bref = (LAS float*)(F.lds + PREP_BREF); LAS float* blast = (LAS float*)(F.lds + PREP_BLAST);
    LAS bf16* QD = (LAS bf16*)(F.lds + PREP_QD); LAS bf16* KD = (LAS bf16*)(F.lds + PREP_KD);
    v4u qraw[4], kraw[4];
#pragma unroll
    for (int r = 0; r < 4; ++r) { const int q = F.tid + 512 * r, row = q >> 5, c = q & 31; const bf16* src = F.PROJ + (size_t)(m0 + row) * NPROJ + C_Q + h * HK + 8 * c;
        qraw[r] = *(const GAS v4u*)src; kraw[r] = *(const GAS v4u*)(src + (C_K - C_Q)); }
    for (int i = F.tid; i < 64 * 16; i += NWAVES * 64) glr_l[i] = F.GLR[(size_t)m0 * 16 + i];
    float wg[16];
#pragma unroll
    for (int r = 0; r < 16; ++r) wg[r] = F.w_gate_up[r * 1024 + h * HK + kd];
    const float bg = F.b_gate[h * HK + kd];
#pragma unroll
    for (int r = 0; r < 4; ++r) { const int q = F.tid + 512 * r, row = q >> 5, c = q & 31; *(LAS v4u*)(QD + row * PREP_PITCH + 8 * c) = qraw[r]; *(LAS v4u*)(KD + row * PREP_PITCH + 8 * c) = kraw[r]; }
    LDS_BARRIER();
    float c[32]; float run = 0.f;
#pragma unroll
    for (int tt = 0; tt < 32; ++tt) { const int t = 32 * half + tt; float z = bg;
#pragma unroll
        for (int r4 = 0; r4 < 4; ++r4) { const f32x4 gv = *(const LAS f32x4*)(glr_l + t * 16 + 4 * r4); z += gv.x * wg[4 * r4] + gv.y * wg[4 * r4 + 1] + gv.z * wg[4 * r4 + 2] + gv.w * wg[4 * r4 + 3]; }
        run += log_sigmoid_f(z) * 0.0625f; c[tt] = run; }
    if (half == 0) tot[kd] = run;
    LDS_BARRIER();
    if (half == 1) { const float add = tot[kd];
#pragma unroll
        for (int tt = 0; tt < 32; ++tt) c[tt] += add;
        bref[kd] = c[0]; blast[kd] = c[31]; F.BLAST[(size_t)bh * HK + kd] = c[31]; }
    LDS_BARRIER();
    const float br = bref[kd], bl = blast[kd], ebr = __expf(br), ebl = __expf(bl - br);
    unsigned klp[16];
    bf16* qdst = F.QE + (size_t)(m0 + 32 * half) * 1024 + h * HK + kd;
#pragma unroll
    for (int tt = 0; tt < 32; tt += 2) { float klv[2];
#pragma unroll
        for (int e = 0; e < 2; ++e) { const int t = 32 * half + tt + e; const float e1 = __expf(c[tt + e] - br), r1 = __builtin_amdgcn_rcpf(e1);
            const float qv = bf2f(QD[t * PREP_PITCH + kd]), kv = bf2f(KD[t * PREP_PITCH + kd]);
            QD[t * PREP_PITCH + kd] = (bf16)f2bf(qv * e1); KD[t * PREP_PITCH + kd] = (bf16)f2bf(kv * r1);
            qdst[(size_t)(tt + e) * 1024] = (bf16)f2bf(qv * e1 * ebr);
            klv[e] = kv * r1 * ebl; }
        klp[tt >> 1] = pk2(klv[0], klv[1]); }
    { GAS v4u* kt = (GAS v4u*)(F.KLT + ((size_t)bh * HK + kd) * 64 + 32 * half);
#pragma unroll
      for (int i = 0; i < 4; ++i) { v4u w; w.x = klp[4 * i]; w.y = klp[4 * i + 1]; w.z = klp[4 * i + 2]; w.w = klp[4 * i + 3]; kt[i] = w; } }
    LDS_BARRIER();
    const int cl = F.lane & 15, g = F.lane >> 4;
#pragma unroll
    for (int rep = 0; rep < 2; ++rep) { const int tile = F.wave + 8 * rep, it = tile >> 2, jt = tile & 3; f32x4 acc = {0.f, 0.f, 0.f, 0.f};
        if (jt <= it) {
#pragma unroll
            for (int kk = 0; kk < 8; ++kk) { const bf16x8 a = *(const LAS bf16x8*)(KD + (16 * jt + cl) * PREP_PITCH + 32 * kk + 8 * g); const bf16x8 b = *(const LAS bf16x8*)(QD + (16 * it + cl) * PREP_PITCH + 32 * kk + 8 * g);
                acc = MFMA16(a, b, acc); } }
        const int i = 16 * it + cl, j0 = 16 * jt + 4 * g;
        v2u w; w.x = pk2(j0 <= i ? acc.x : 0.f, j0 + 1 <= i ? acc.y : 0.f); w.y = pk2(j0 + 2 <= i ? acc.z : 0.f, j0 + 3 <= i ? acc.w : 0.f);
        *(GAS v2u*)(F.ATT + (size_t)bh * 4096 + i * 64 + j0) = w; }
    LDS_BARRIER();
}
constexpr int VT_PITCH = 520;
static_assert(64 * VT_PITCH * 2 <= RING_BYTES, "vt LDS");
__device__ __forceinline__ void v_transpose_unit(Frame& F, int bh) {
    const int blk = bh >> 2, h = bh & 3, m0 = 64 * blk; LAS bf16* tile = (LAS bf16*)F.lds;
    { const int row = F.tid >> 3, piece = F.tid & 7; const GAS v4u* src = (const GAS v4u*)(F.PROJ + (size_t)(m0 + row) * NPROJ + C_VV + h * HV + piece * 64);
      LAS v4u* dst = (LAS v4u*)(tile + row * VT_PITCH + piece * 64);
#pragma unroll
      for (int i = 0; i < 8; ++i) dst[i] = src[i]; }
    LDS_BARRIER();
    { const int e = F.tid; unsigned p[32];
#pragma unroll
      for (int j = 0; j < 64; j += 2) p[j >> 1] = (unsigned)tile[j * VT_PITCH + e] | ((unsigned)tile[(j + 1) * VT_PITCH + e] << 16);
      GAS v4u* dst = (GAS v4u*)(F.VT + ((size_t)bh * HV + e) * 64);
#pragma unroll
      for (int i = 0; i < 8; ++i) { v4u w; w.x = p[4 * i]; w.y = p[4 * i + 1]; w.z = p[4 * i + 2]; w.w = p[4 * i + 3]; dst[i] = w; } }
    LDS_BARRIER();
}

constexpr int SGU_PITCH = 136;
struct SguPre { v4u vr[4]; v2u uw[8]; float s1, s2; };
__device__ __forceinline__ void sgu_prefetch(Frame& F, int un, SguPre& o) {
    const int ck = un >> 4, a = un & 15; const int m0 = ck < 128 ? 128 * ck : MP + 64 * (ck - 128), clen = ck < 128 ? 128 : 64;
    const int it = F.wave, cl = F.lane & 15, g = F.lane >> 4;
    const bool act = 16 * it < clen; const int i = act ? 16 * it + cl : 0;
    { const int j = F.tid >> 2, qd = F.tid & 3;
      if (j < clen) { const int m = m0 + j; const GAS v4u* src = (const GAS v4u*)(F.PROJ + (size_t)m * NPROJ + C_V + a * AHD + 32 * qd);
#pragma unroll
          for (int q = 0; q < 4; ++q) o.vr[q] = src[q];
          o.s1 = ((const float*)(F.ctl + CW_VST))[2 * m]; o.s2 = ((const float*)(F.ctl + CW_VST))[2 * m + 1]; } }
    { const bf16* urow = F.PROJ + (size_t)(m0 + i) * NPROJ + C_U + a * AHD + 4 * g;
#pragma unroll
      for (int dt = 0; dt < 8; ++dt) o.uw[dt] = *(const GAS v2u*)(urow + 16 * dt); }
}
struct SguW { v4u bw[4]; float bs; int a; float lg[32], lb[32]; };
__device__ __forceinline__ void sgu_unit(Frame& F, int un, SguPre& cur, int un_next, SguW& W) {
    const int ck = un >> 4, a = un & 15; const int m0 = ck < 128 ? 128 * ck : MP + 64 * (ck - 128), clen = ck < 128 ? 128 : 64;
    LAS bf16* VnT = (LAS bf16*)F.lds;
    const int it = F.wave, cl = F.lane & 15, g = F.lane >> 4;
    const bool act = 16 * it < clen; const int i = act ? 16 * it + cl : 0, nk = (it >> 1) + 1;
    if (W.a != a) {
        const int iw = 16 * it + cl;
#pragma unroll
        for (int kk = 0; kk < 4; ++kk) { const float* wrow = F.w_s + ((size_t)a * 128 + iw) * 128 + 32 * kk + 8 * g; const f32x4 w0 = *(const f32x4*)wrow, w1 = *(const f32x4*)(wrow + 4);
            const int j0 = 32 * kk + 8 * g;
            W.bw[kk].x = pk2(j0 <= iw ? w0.x : 0.f, j0 + 1 <= iw ? w0.y : 0.f); W.bw[kk].y = pk2(j0 + 2 <= iw ? w0.z : 0.f, j0 + 3 <= iw ? w0.w : 0.f);
            W.bw[kk].z = pk2(j0 + 4 <= iw ? w1.x : 0.f, j0 + 5 <= iw ? w1.y : 0.f); W.bw[kk].w = pk2(j0 + 6 <= iw ? w1.z : 0.f, j0 + 7 <= iw ? w1.w : 0.f); }
        W.bs = F.b_s[a * 128 + iw]; W.a = a;
        { const int qd = F.tid & 3; const f32x4* lg4 = (const f32x4*)(F.ln_g + a * AHD + 32 * qd); const f32x4* lb4 = (const f32x4*)(F.ln_b + a * AHD + 32 * qd);
#pragma unroll
          for (int q = 0; q < 8; ++q) { const f32x4 x = lg4[q], y = lb4[q]; W.lg[4 * q] = x.x; W.lg[4 * q + 1] = x.y; W.lg[4 * q + 2] = x.z; W.lg[4 * q + 3] = x.w; W.lb[4 * q] = y.x; W.lb[4 * q + 1] = y.y; W.lb[4 * q + 2] = y.z; W.lb[4 * q + 3] = y.w; } } }
    const float bs = W.bs;
    { const int j = F.tid >> 2, qd = F.tid & 3;
      if (j < clen) { const float mu = cur.s1 * (1.f / AWID), rs = 1.0f / sqrtf(fmaxf(cur.s2 * (1.f / AWID) - mu * mu, 0.f) + EPS);
#pragma unroll
          for (int q = 0; q < 4; ++q) { const v4u w = cur.vr[q]; const float f[8] = {bflo(w.x), bfhi(w.x), bflo(w.y), bfhi(w.y), bflo(w.z), bfhi(w.z), bflo(w.w), bfhi(w.w)};
#pragma unroll
              for (int k = 0; k < 8; ++k) { const int d = 8 * q + k; VnT[(32 * qd + d) * SGU_PITCH + j] = (bf16)f2bf((f[k] - mu) * rs * W.lg[d] + W.lb[d]); } } } }
    v2u uw[8];
#pragma unroll
    for (int dt = 0; dt < 8; ++dt) uw[dt] = cur.uw[dt];
    LDS_BARRIER();
    if (un_next >= 0) sgu_prefetch(F, un_next, cur);
    if (act) {
        f32x4 acc[8];
#pragma unroll
        for (int dt = 0; dt < 8; ++dt) acc[dt] = (f32x4){0.f, 0.f, 0.f, 0.f};
#pragma unroll
        for (int kk = 0; kk < 4; ++kk) if (kk < nk) {
            const bf16x8 bfrag = __builtin_bit_cast(bf16x8, W.bw[kk]);
#pragma unroll
            for (int dt = 0; dt < 8; ++dt) { const bf16x8 afrag = *(const LAS bf16x8*)(VnT + (16 * dt + cl) * SGU_PITCH + 32 * kk + 8 * g); acc[dt] = MFMA16(afrag, bfrag, acc[dt]); } }
        bf16* orow = F.MIX + (size_t)(m0 + i) * DM + a * AHD + 4 * g;
#pragma unroll
        for (int dt = 0; dt < 8; ++dt) {
            v2u w; w.x = pk2(bflo(uw[dt].x) * (acc[dt].x + bs), bfhi(uw[dt].x) * (acc[dt].y + bs)); w.y = pk2(bflo(uw[dt].y) * (acc[dt].z + bs), bfhi(uw[dt].y) * (acc[dt].w + bs));
            *(GAS v2u*)(orow + 16 * dt) = w; }
    }
    LDS_BARRIER();
}

struct ChainRegs { f32x4 S[2][4]; };
struct ChainOpsU { bf16x8 ka[2][2]; bf16x8 vb[4][2]; f32x4 bl[2]; };
struct ChainOpsO { bf16x8 qb[8]; bf16x8 ab[2]; };
__device__ __forceinline__ void chain_load_u(const Frame& F, int bh, int wv, int g, int cl, int es, ChainOpsU& P) {
#pragma unroll
    for (int dt = 0; dt < 2; ++dt)
#pragma unroll
        for (int kk = 0; kk < 2; ++kk) P.ka[dt][kk] = *(const GAS bf16x8*)(F.KLT + ((size_t)bh * HK + 32 * wv + 16 * dt + cl) * 64 + 32 * kk + 8 * g);
#pragma unroll
    for (int et = 0; et < 4; ++et)
#pragma unroll
        for (int kk = 0; kk < 2; ++kk) P.vb[et][kk] = *(const GAS bf16x8*)(F.VT + ((size_t)bh * HV + 64 * es + 16 * et + cl) * 64 + 32 * kk + 8 * g);
#pragma unroll
    for (int dt = 0; dt < 2; ++dt) P.bl[dt] = *(const GAS f32x4*)(F.BLAST + (size_t)bh * HK + 32 * wv + 16 * dt + 4 * g);
}
__device__ __forceinline__ void chain_load_o(const Frame& F, int blk, int h, int it, int g, int cl, ChainOpsO& P) {
    const bf16* qrow = F.QE + (size_t)(64 * blk + 16 * it + cl) * 1024 + h * HK + 8 * g;
#pragma unroll
    for (int kk = 0; kk < 8; ++kk) P.qb[kk] = *(const GAS bf16x8*)(qrow + 32 * kk);
#pragma unroll
    for (int kk = 0; kk < 2; ++kk) P.ab[kk] = *(const GAS bf16x8*)(F.ATT + (size_t)(blk * 4 + h) * 4096 + (16 * it + cl) * 64 + 32 * kk + 8 * g);
}
__device__ __forceinline__ void chain_update(ChainRegs& R, const ChainOpsU& P) {
#pragma unroll
    for (int dt = 0; dt < 2; ++dt) { f32x4 dec; dec.x = __expf(P.bl[dt].x); dec.y = __expf(P.bl[dt].y); dec.z = __expf(P.bl[dt].z); dec.w = __expf(P.bl[dt].w);
#pragma unroll
        for (int et = 0; et < 4; ++et) { f32x4 s = R.S[dt][et] * dec;
#pragma unroll
            for (int kk = 0; kk < 2; ++kk) s = MFMA16(P.ka[dt][kk], P.vb[et][kk], s);
            R.S[dt][et] = s; } }
}
__device__ __forceinline__ void chain_load(const float* base, int wv, int g, int cl, int es, ChainRegs& R) {
#pragma unroll
    for (int dt = 0; dt < 2; ++dt)
#pragma unroll
        for (int et = 0; et < 4; ++et) { const float* p = base + (size_t)(32 * wv + 16 * dt + 4 * g) * HV + 64 * es + 16 * et + cl;
            R.S[dt][et] = (f32x4){p[0], p[HV], p[2 * HV], p[3 * HV]}; }
}
__device__ __forceinline__ void chain_store(float* base, int wv, int g, int cl, int es, const ChainRegs& R) {
#pragma unroll
    for (int dt = 0; dt < 2; ++dt)
#pragma unroll
        for (int et = 0; et < 4; ++et) { float* p = base + (size_t)(32 * wv + 16 * dt + 4 * g) * HV + 64 * es + 16 * et + cl;
            p[0] = R.S[dt][et].x; p[HV] = R.S[dt][et].y; p[2 * HV] = R.S[dt][et].z; p[3 * HV] = R.S[dt][et].w; }
}
__device__ __forceinline__ void lst_store(float* base, int wv, int es, int lane, const ChainRegs& R) {
    GAS f32x4* p = (GAS f32x4*)base + ((size_t)(es * 8 + wv) * 8) * 64 + lane;
#pragma unroll
    for (int dt = 0; dt < 2; ++dt)
#pragma unroll
        for (int et = 0; et < 4; ++et) p[(dt * 4 + et) * 64] = R.S[dt][et];
}
__device__ __forceinline__ void lst_load(const float* base, int wv, int es, int lane, ChainRegs& R) {
    const GAS f32x4* p = (const GAS f32x4*)base + ((size_t)(es * 8 + wv) * 8) * 64 + lane;
#pragma unroll
    for (int dt = 0; dt < 2; ++dt)
#pragma unroll
        for (int et = 0; et < 4; ++et) R.S[dt][et] = p[(dt * 4 + et) * 64];
}
__device__ __forceinline__ void chain_decode(int un, int& gs, int& h, int& es) { const int x = un & 7, idx = (un >> 3) & 31, hi = un >> 8; const int gh = x * 4 + (idx >> 3); es = idx & 7; h = gh & 3; gs = hi * 8 + (gh >> 2); }
struct ChainOpsK1 { bf16x8 ka[2][2]; f32x4 bl[2]; };
__device__ __forceinline__ void chain_load_k1(const Frame& F, int bh, int wv, int g, int cl, ChainOpsK1& P) {
#pragma unroll
    for (int dt = 0; dt < 2; ++dt)
#pragma unroll
        for (int kk = 0; kk < 2; ++kk) P.ka[dt][kk] = *(const GAS bf16x8*)(F.KLT + ((size_t)bh * HK + 32 * wv + 16 * dt + cl) * 64 + 32 * kk + 8 * g);
#pragma unroll
    for (int dt = 0; dt < 2; ++dt) P.bl[dt] = *(const GAS f32x4*)(F.BLAST + (size_t)bh * HK + 32 * wv + 16 * dt + 4 * g);
}
constexpr int P1V_PITCH = 72;
__device__ __forceinline__ void chain_step_kv(ChainRegs& R, const ChainOpsK1& P, const LAS bf16* vimg, int g, int cl) {
    bf16x8 vb[4][2];
#pragma unroll
    for (int et = 0; et < 4; ++et)
#pragma unroll
        for (int kk = 0; kk < 2; ++kk) vb[et][kk] = *(const LAS bf16x8*)(vimg + (16 * et + cl) * P1V_PITCH + 32 * kk + 8 * g);
#pragma unroll
    for (int dt = 0; dt < 2; ++dt) { f32x4 dec; dec.x = __expf(P.bl[dt].x); dec.y = __expf(P.bl[dt].y); dec.z = __expf(P.bl[dt].z); dec.w = __expf(P.bl[dt].w);
#pragma unroll
        for (int et = 0; et < 4; ++et) { f32x4 s = R.S[dt][et] * dec;
#pragma unroll
            for (int kk = 0; kk < 2; ++kk) s = MFMA16(P.ka[dt][kk], vb[et][kk], s);
            R.S[dt][et] = s; } }
}
__device__ __forceinline__ void chain_pass1_unit(Frame& F, int un) {
    int gp, h, es; chain_decode(un, gp, h, es); const int wv = F.wave, g = F.lane >> 4, cl = F.lane & 15;
    if (gp >= NG - 1) return;
    ChainRegs R;
#pragma unroll
    for (int dt = 0; dt < 2; ++dt)
#pragma unroll
        for (int et = 0; et < 4; ++et) R.S[dt][et] = (f32x4){0.f, 0.f, 0.f, 0.f};
    f32x4 bsum[2] = {{0.f, 0.f, 0.f, 0.f}, {0.f, 0.f, 0.f, 0.f}};
    LAS bf16* VB = (LAS bf16*)F.lds;
    const int prow = 8 * wv + (F.lane >> 3), pcol = 8 * (F.lane & 7), poff = prow * P1V_PITCH + pcol;
    const bf16* pbase = F.VT + ((size_t)64 * es + prow) * 64 + pcol;
    ChainOpsK1 PA, PB; const int bh0 = (GB * gp) * 4 + h;
    bf16x8 pc0 = *(const GAS bf16x8*)(pbase + (size_t)bh0 * HV * 64), pc1 = *(const GAS bf16x8*)(pbase + (size_t)(bh0 + 4) * HV * 64);
    chain_load_k1(F, bh0, wv, g, cl, PA);
    *(LAS bf16x8*)(VB + poff) = pc0;
    LDS_BARRIER();
    for (int s = 0; s < GB; s += 2) {
        chain_load_k1(F, bh0 + 4 * (s + 1), wv, g, cl, PB);
        pc0 = *(const GAS bf16x8*)(pbase + (size_t)(bh0 + 4 * (s + 2 < GB ? s + 2 : s)) * HV * 64);
        *(LAS bf16x8*)(VB + 64 * P1V_PITCH + poff) = pc1;
        chain_step_kv(R, PA, VB, g, cl); bsum[0] += PA.bl[0]; bsum[1] += PA.bl[1];
        LDS_BARRIER();
        chain_load_k1(F, bh0 + 4 * (s + 2 < GB ? s + 2 : s), wv, g, cl, PA);
        pc1 = *(const GAS bf16x8*)(pbase + (size_t)(bh0 + 4 * (s + 3 < GB ? s + 3 : s)) * HV * 64);
        *(LAS bf16x8*)(VB + poff) = pc0;
        chain_step_kv(R, PB, VB + 64 * P1V_PITCH, g, cl); bsum[0] += PB.bl[0]; bsum[1] += PB.bl[1];
        LDS_BARRIER();
    }
    lst_store(F.LST + (size_t)(gp * 4 + h) * HK * HV, wv, es, F.lane, R);
    if (es == 0 && cl == 0) { *(GAS f32x4*)(F.GDEC + (size_t)(gp * 4 + h) * HK + 32 * wv + 4 * g) = bsum[0]; *(GAS f32x4*)(F.GDEC + (size_t)(gp * 4 + h) * HK + 32 * wv + 16 + 4 * g) = bsum[1]; }
}
constexpr int SL_PITCH = 264, SL_BYTES = 64 * SL_PITCH * 2, AL_PITCH = 72, AL_BYTES = 64 * AL_PITCH * 2;
constexpr int CH_SL = 0, CH_QL = SL_BYTES, CH_AL = 2 * SL_BYTES, CH_VL = CH_AL + AL_BYTES, CH_END = CH_VL + AL_BYTES;
static_assert(CH_END <= RING_BYTES, "chain LDS");
struct ChainStage { v4u q[4]; v4u a; v4u v; };
struct ChainOpsK { bf16x8 ka[2][2]; f32x4 bl[2]; };
__device__ __forceinline__ void chain_stage_load(const Frame& F, int blk, int h, int es, ChainStage& T) {
    const int bh = blk * 4 + h;
#pragma unroll
    for (int k = 0; k < 4; ++k) { const int q = F.tid + 512 * k, row = q >> 5, c = q & 31; T.q[k] = *(const GAS v4u*)(F.QE + (size_t)(64 * blk + row) * 1024 + h * HK + 8 * c); }
    const int row = F.tid >> 3, c = F.tid & 7;
    T.a = *(const GAS v4u*)(F.ATT + (size_t)bh * 4096 + row * 64 + 8 * c);
    T.v = *(const GAS v4u*)(F.VT + ((size_t)bh * HV + 64 * es + row) * 64 + 8 * c);
}
__device__ __forceinline__ void chain_stage_write(const Frame& F, const ChainStage& T) {
#pragma unroll
    for (int k = 0; k < 4; ++k) { const int q = F.tid + 512 * k, row = q >> 5, c = q & 31; *(LAS v4u*)(F.lds + CH_QL + (row * SL_PITCH + 8 * c) * 2) = T.q[k]; }
    const int row = F.tid >> 3, c = F.tid & 7;
    *(LAS v4u*)(F.lds + CH_AL + (row * AL_PITCH + 8 * c) * 2) = T.a;
    *(LAS v4u*)(F.lds + CH_VL + (row * AL_PITCH + 8 * c) * 2) = T.v;
}
__device__ __forceinline__ void chain_load_k(const Frame& F, int bh, int wv, int g, int cl, ChainOpsK& P) {
#pragma unroll
    for (int dt = 0; dt < 2; ++dt)
#pragma unroll
        for (int kk = 0; kk < 2; ++kk) P.ka[dt][kk] = *(const GAS bf16x8*)(F.KLT + ((size_t)bh * HK + 32 * wv + 16 * dt + cl) * 64 + 32 * kk + 8 * g);
#pragma unroll
    for (int dt = 0; dt < 2; ++dt) P.bl[dt] = *(const GAS f32x4*)(F.BLAST + (size_t)bh * HK + 32 * wv + 16 * dt + 4 * g);
}
__device__ __forceinline__ void chain_write_sl(LAS unsigned char* sl, int wv, int g, int cl, const ChainRegs& R) {
#pragma unroll
    for (int dt = 0; dt < 2; ++dt)
#pragma unroll
        for (int et = 0; et < 4; ++et) { v2u w; w.x = pk2(R.S[dt][et].x, R.S[dt][et].y); w.y = pk2(R.S[dt][et].z, R.S[dt][et].w);
            *(LAS v2u*)(sl + ((16 * et + cl) * SL_PITCH + 32 * wv + 16 * dt + 4 * g) * 2) = w; }
}
__device__ __forceinline__ void chain_step_compute(Frame& F, int blk, int h, int es, ChainRegs& R, const ChainOpsK& PK) {
    const int wv = F.wave, g = F.lane >> 4, cl = F.lane & 15, it = wv >> 1, eh = wv & 1;
    const LAS unsigned char* sl = F.lds + CH_SL; const LAS unsigned char* ql = F.lds + CH_QL; const LAS unsigned char* al = F.lds + CH_AL; const LAS unsigned char* vl = F.lds + CH_VL;
    f32x4 o0 = {0.f, 0.f, 0.f, 0.f}, o1 = {0.f, 0.f, 0.f, 0.f};
#pragma unroll 1
    for (int k2 = 0; k2 < 8; k2 += 2) {
#pragma unroll
        for (int kq = 0; kq < 2; ++kq) { const int kk = k2 + kq; const bf16x8 qb = *(const LAS bf16x8*)(ql + ((16 * it + cl) * SL_PITCH + 32 * kk + 8 * g) * 2);
            const bf16x8 s0 = *(const LAS bf16x8*)(sl + ((16 * (2 * eh) + cl) * SL_PITCH + 32 * kk + 8 * g) * 2), s1 = *(const LAS bf16x8*)(sl + ((16 * (2 * eh + 1) + cl) * SL_PITCH + 32 * kk + 8 * g) * 2);
            o0 = MFMA16(s0, qb, o0); o1 = MFMA16(s1, qb, o1); } }
#pragma unroll
    for (int kk = 0; kk < 2; ++kk) { const bf16x8 ab = *(const LAS bf16x8*)(al + ((16 * it + cl) * AL_PITCH + 32 * kk + 8 * g) * 2);
        const bf16x8 v0 = *(const LAS bf16x8*)(vl + ((16 * (2 * eh) + cl) * AL_PITCH + 32 * kk + 8 * g) * 2), v1 = *(const LAS bf16x8*)(vl + ((16 * (2 * eh + 1) + cl) * AL_PITCH + 32 * kk + 8 * g) * 2);
        o0 = MFMA16(v0, ab, o0); o1 = MFMA16(v1, ab, o1); }
    { bf16* orow = F.O + (size_t)(64 * blk + 16 * it + cl) * 2048 + h * HV + 64 * es + 32 * eh + 4 * g;
      v2u w; w.x = pk2(o0.x, o0.y); w.y = pk2(o0.z, o0.w); *(GAS v2u*)orow = w; w.x = pk2(o1.x, o1.y); w.y = pk2(o1.z, o1.w); *(GAS v2u*)(orow + 16) = w; }
    f32x4 dec[2];
#pragma unroll
    for (int dt = 0; dt < 2; ++dt) { dec[dt].x = __expf(PK.bl[dt].x); dec[dt].y = __expf(PK.bl[dt].y); dec[dt].z = __expf(PK.bl[dt].z); dec[dt].w = __expf(PK.bl[dt].w); }
#pragma unroll
    for (int et = 0; et < 4; ++et) {
        const bf16x8 vb0 = *(const LAS bf16x8*)(vl + ((16 * et + cl) * AL_PITCH + 8 * g) * 2), vb1 = *(const LAS bf16x8*)(vl + ((16 * et + cl) * AL_PITCH + 32 + 8 * g) * 2);
#pragma unroll
        for (int dt = 0; dt < 2; ++dt) { f32x4 s = R.S[dt][et] * dec[dt]; s = MFMA16(PK.ka[dt][0], vb0, s); s = MFMA16(PK.ka[dt][1], vb1, s); R.S[dt][et] = s; }
        __builtin_amdgcn_sched_barrier(0); }
}
__device__ __forceinline__ void chain_steps_o(Frame& F, int blk0, int nsteps, int h, int es, ChainRegs& R) {
    const int wv = F.wave, g = F.lane >> 4, cl = F.lane & 15, last = blk0 + nsteps - 1;
    ChainStage TA, TB; ChainOpsK K;
    chain_stage_load(F, blk0, h, es, TA); chain_load_k(F, blk0 * 4 + h, wv, g, cl, K);
    { const int b1 = blk0 + 1 <= last ? blk0 + 1 : last; chain_stage_load(F, b1, h, es, TB); }
    chain_write_sl(F.lds + CH_SL, wv, g, cl, R); chain_stage_write(F, TA);
    LDS_BARRIER();
    if (nsteps == 1) { chain_step_compute(F, blk0, h, es, R, K); LDS_BARRIER(); return; }
    for (int s = 0; s < nsteps; s += 2) {
        { const int b1 = blk0 + s + 1, b2 = blk0 + s + 2 <= last ? blk0 + s + 2 : last; chain_stage_load(F, b2, h, es, TA);
          chain_step_compute(F, blk0 + s, h, es, R, K);
          chain_load_k(F, b1 * 4 + h, wv, g, cl, K); }
        LDS_BARRIER();
        chain_write_sl(F.lds + CH_SL, wv, g, cl, R); chain_stage_write(F, TB);
        LDS_BARRIER();
        { const int b2 = blk0 + s + 2 <= last ? blk0 + s + 2 : last, b3 = blk0 + s + 3 <= last ? blk0 + s + 3 : last; chain_stage_load(F, b3, h, es, TB);
          chain_step_compute(F, blk0 + s + 1, h, es, R, K);
          chain_load_k(F, b2 * 4 + h, wv, g, cl, K); }
        LDS_BARRIER();
        chain_write_sl(F.lds + CH_SL, wv, g, cl, R); chain_stage_write(F, TA);
        LDS_BARRIER();
    }
}
__device__ __forceinline__ void chain_pass2_prompt_unit(Frame& F, int un) {
    int gp, h, es; chain_decode(un, gp, h, es); const int wv = F.wave, g = F.lane >> 4, cl = F.lane & 15;
    ChainRegs R;
#pragma unroll
    for (int dt = 0; dt < 2; ++dt)
#pragma unroll
        for (int et = 0; et < 4; ++et) R.S[dt][et] = (f32x4){0.f, 0.f, 0.f, 0.f};
    ChainRegs LA; f32x4 ga[2];
    if (gp > 0) { lst_load(F.LST + (size_t)h * HK * HV, wv, es, F.lane, LA);
#pragma unroll
        for (int dt = 0; dt < 2; ++dt) ga[dt] = *(const GAS f32x4*)(F.GDEC + (size_t)h * HK + 32 * wv + 16 * dt + 4 * g); }
    for (int q = 0; q < gp; ++q) {
        ChainRegs LB; f32x4 gb[2]; const int qn = q + 1 < gp ? q + 1 : q;
        lst_load(F.LST + (size_t)(qn * 4 + h) * HK * HV, wv, es, F.lane, LB);
#pragma unroll
        for (int dt = 0; dt < 2; ++dt) gb[dt] = *(const GAS f32x4*)(F.GDEC + (size_t)(qn * 4 + h) * HK + 32 * wv + 16 * dt + 4 * g);
#pragma unroll
        for (int dt = 0; dt < 2; ++dt) { const f32x4 gd = ga[dt];
            f32x4 dec; dec.x = __expf(gd.x); dec.y = __expf(gd.y); dec.z = __expf(gd.z); dec.w = __expf(gd.w);
#pragma unroll
            for (int et = 0; et < 4; ++et) R.S[dt][et] = R.S[dt][et] * dec + LA.S[dt][et]; }
#pragma unroll
        for (int dt = 0; dt < 2; ++dt) { ga[dt] = gb[dt];
#pragma unroll
            for (int et = 0; et < 4; ++et) LA.S[dt][et] = LB.S[dt][et]; } }
    chain_steps_o(F, GB * gp, GB, h, es, R);
    if (gp == NG - 1) chain_store(F.out + O_GP + (size_t)h * HK * HV, wv, g, cl, es, R);
}
__device__ __forceinline__ void chain_sample_unit(Frame& F, int un) {
    int st, h, es; chain_decode(un, st, h, es); const int wv = F.wave, g = F.lane >> 4, cl = F.lane & 15;
    ChainRegs R; chain_load(F.state_gla + (size_t)(st * 4 + h) * HK * HV, wv, g, cl, es, R);
    chain_steps_o(F, MP / 64 + st, 1, h, es, R);
    chain_store(F.out + O_GS + (size_t)(st * 4 + h) * HK * HV, wv, g, cl, es, R);
}

__device__ __forceinline__ void gla_finish_load(const Frame& F, int m, v4u (&w)[4], v4u (&rw)[4]) {
    const GAS v4u* orow = (const GAS v4u*)(F.O + (size_t)m * 2048) + F.lane; const GAS v4u* rrow = (const GAS v4u*)(F.PROJ + (size_t)m * NPROJ + C_R) + F.lane;
#pragma unroll
    for (int hh = 0; hh < 4; ++hh) { w[hh] = orow[64 * hh]; rw[hh] = rrow[64 * hh]; }
}
__device__ __forceinline__ void gla_finish_rows(Frame& F, int gw, int NGW) {
    const f32x4 g0 = *(const f32x4*)(F.gla_norm_g + 8 * F.lane), g1 = *(const f32x4*)(F.gla_norm_g + 8 * F.lane + 4);
    v4u wA[4], rA[4];
    if (gw < M) gla_finish_load(F, gw, wA, rA);
    for (int m = gw; m < M; m += NGW) {
        v4u wB[4], rB[4]; const int mn = m + NGW < M ? m + NGW : m;
        gla_finish_load(F, mn, wB, rB);
        GAS v4u* drow = (GAS v4u*)(F.MIX + (size_t)m * DM + 2048) + F.lane;
#pragma unroll
        for (int hh = 0; hh < 4; ++hh) { const v4u w = wA[hh], rw = rA[hh];
            const float f[8] = {bflo(w.x), bfhi(w.x), bflo(w.y), bfhi(w.y), bflo(w.z), bfhi(w.z), bflo(w.w), bfhi(w.w)};
            const float r[8] = {bflo(rw.x), bfhi(rw.x), bflo(rw.y), bfhi(rw.y), bflo(rw.z), bfhi(rw.z), bflo(rw.w), bfhi(rw.w)};
            float s = 0.f;
#pragma unroll
            for (int k = 0; k < 8; ++k) s += f[k] * f[k];
            const float rstd = 1.0f / sqrtf(wave_sum(s) * (1.f / HV) + EPS);
            v4u ow; ow.x = pk2hw(f[0] * rstd * g0.x * r[0], f[1] * rstd * g0.y * r[1]); ow.y = pk2hw(f[2] * rstd * g0.z * r[2], f[3] * rstd * g0.w * r[3]);
            ow.z = pk2hw(f[4] * rstd * g1.x * r[4], f[5] * rstd * g1.y * r[5]); ow.w = pk2hw(f[6] * rstd * g1.z * r[6], f[7] * rstd * g1.w * r[7]);
            drow[64 * hh] = ow; }
#pragma unroll
        for (int hh = 0; hh < 4; ++hh) { wA[hh] = wB[hh]; rA[hh] = rB[hh]; }
    }
}
__device__ __forceinline__ void final_norm_rows(Frame& F, int gw, int NGW) {
    const GAS f32x4* gr = (const GAS f32x4*)F.g_final; f32x4 g0[8], g1[8];
#pragma unroll
    for (int j = 0; j < 8; ++j) { const int c4 = 2 * (F.lane + 64 * j); g0[j] = gr[c4]; g1[j] = gr[c4 + 1]; }
    for (int m = gw; m < M; m += NGW) {
        const GAS v4u* xr = (const GAS v4u*)(F.HN + (size_t)m * DM) + F.lane; GAS f32x4* yr = (GAS f32x4*)(F.out + (size_t)m * DM);
        const float rstd = 1.0f / sqrtf(((const float*)(F.ctl + CW_SSQ2))[m] * (1.f / DM) + EPS);
        v4u w[8];
#pragma unroll
        for (int j = 0; j < 8; ++j) w[j] = xr[64 * j];
#pragma unroll
        for (int j = 0; j < 8; ++j) { const int c4 = 2 * (F.lane + 64 * j);
            f32x4 y0, y1; y0.x = bflo(w[j].x) * rstd * g0[j].x; y0.y = bfhi(w[j].x) * rstd * g0[j].y; y0.z = bflo(w[j].y) * rstd * g0[j].z; y0.w = bfhi(w[j].y) * rstd * g0[j].w;
            y1.x = bflo(w[j].z) * rstd * g1[j].x; y1.y = bfhi(w[j].z) * rstd * g1[j].y; y1.z = bflo(w[j].w) * rstd * g1[j].z; y1.w = bfhi(w[j].w) * rstd * g1[j].w;
            yr[c4] = y0; yr[c4 + 1] = y1; }
    }
}

#ifndef P9_WGM
#define P9_WGM 4
#endif
#ifndef GWGM
#define GWGM 9
#endif
#ifndef GWGM_P1
#define GWGM_P1 GWGM
#endif
#ifndef ALIGN_P6
#define ALIGN_P6 true
#endif
#ifndef GEMM_SP2
#define GEMM_SP2 true
#endif
#ifndef ALIGN_P1
#define ALIGN_P1 true
#endif
#ifndef ALIGN_P8
#define ALIGN_P8 true
#endif
#define PHASE_BEGIN(k) _Pragma("unroll") for (int _rep = 0; _rep < 1; ++_rep) {
#define PHASE_END(k) xcd_barrier(bar); }
struct Args { const float* in[18]; float* out; unsigned char* ws; };
__global__ void __launch_bounds__(NWAVES * 64, 2) fwd_kernel(Args args) {
    extern __shared__ __attribute__((aligned(16))) unsigned char lds[];
    Frame F;
    F.lds = (LAS unsigned char*)lds;
    F.tid = threadIdx.x; F.lane = F.tid & 63; F.wave = __builtin_amdgcn_readfirstlane(F.tid >> 6); F.G = gridDim.x; F.wg = blockIdx.x;
    unsigned char* ws = args.ws;
    F.ctl = (unsigned*)(ws + WS_CTL);
    F.x_prompt = args.in[0]; F.x_sample = args.in[1]; F.state_gla = args.in[2]; F.g_mix = args.in[3]; F.w_in = args.in[4]; F.w_s = args.in[5]; F.b_s = args.in[6]; F.ln_g = args.in[7]; F.ln_b = args.in[8];
    F.w_gate_up = args.in[9]; F.b_gate = args.in[10]; F.gla_norm_g = args.in[11]; F.w_out = args.in[12]; F.g_ffn = args.in[13]; F.w_ffn_gate = args.in[14]; F.w_ffn_up = args.in[15]; F.w_ffn_down = args.in[16]; F.g_final = args.in[17];
    F.out = args.out;
    F.WIN = (bf16*)(ws + WS_WIN); F.WOUT = (bf16*)(ws + WS_WOUT); F.WGU = (bf16*)(ws + WS_WGU); F.WDN = (bf16*)(ws + WS_WDN); F.HN = (bf16*)(ws + WS_HN); F.PROJ = (bf16*)(ws + WS_PROJ);
    F.MIX = (bf16*)(ws + WS_MIX); F.QE = (bf16*)(ws + WS_QE); F.KLT = (bf16*)(ws + WS_KLT); F.ATT = (bf16*)(ws + WS_ATT); F.VT = (bf16*)(ws + WS_VT); F.O = (bf16*)(ws + WS_O); F.HFF = (bf16*)(ws + WS_HFF);
    F.GLR = (float*)(ws + WS_GLR); F.STATS = (float*)(ws + WS_STATS); F.BLAST = (float*)(ws + WS_BLAST); F.LST = (float*)(ws + WS_LST); F.GDEC = (float*)(ws + WS_GDEC);
    for (int u = F.tid; u < (LDS_BYTES - PHASE_LDS) / 4; u += NWAVES * 64) ((LAS unsigned*)(F.lds + PHASE_LDS))[u] = 0u;
    __syncthreads();
    XcdBarrier bar = xcd_barrier_post(F.ctl + CW_BAR, (volatile LAS unsigned*)(F.lds + MISC_OFF + 32));
    const int gw = F.wg * NWAVES + F.wave, NGW = F.G * NWAVES;
    if (F.tid == 0) ((volatile LAS unsigned*)(F.lds + MISC_OFF))[0] = __hip_atomic_fetch_add(F.ctl + CW_XRANK + 16 * bar.x, 1u, __ATOMIC_RELAXED, __HIP_MEMORY_SCOPE_AGENT);
    F.wgv = F.wg;

    PHASE_BEGIN(0)
    p0_prologue(F);
    PHASE_END(0)
    {
        volatile LAS unsigned* misc = (volatile LAS unsigned*)(F.lds + MISC_OFF);
        if (F.tid == 0) { bool even = (F.G % 8) == 0; for (int j = 0; j < 8; ++j) even = even && (__hip_atomic_load(F.ctl + CW_XRANK + 16 * j, __ATOMIC_RELAXED, __HIP_MEMORY_SCOPE_AGENT) == (unsigned)(F.G / 8));
            misc[1] = (even && bar.x < 8u) ? bar.x + 8u * misc[0] : (unsigned)F.wg; }
        __syncthreads();
        F.wgv = __builtin_amdgcn_readfirstlane((int)misc[1]);
    }
    PHASE_BEGIN(1)
    { constexpr int FFN_END = P0_I_OUT + 2 * P0_I_G + P0_I_D;
      const int GG = F.G == 256 ? F.G - 8 : F.G;
      if (F.wgv >= GG) convert_items_pipelined(F, FFN_END - P0_MOVED - P1_DED, FFN_END - P0_MOVED, (F.wgv - GG) * NWAVES + F.wave, (F.G - GG) * NWAVES);
      else {
      pg8::Gemm g{F.HN, F.WIN, M, NPAD, DM}; pg8::StaticOrder S; S.init(M, NPAD, GG, F.wgv, GWGM_P1); pg8::EpiProj E{F.PROJ, F.GLR, (float*)(F.ctl + CW_VST)};
      pg8::gemm_phase<pg8::EpiProj, pg8::StaticOrder, ALIGN_P1, GEMM_SP2>(F.lds, g, S, E);
      { const int nwg = (M / 256) * (NPAD / 256), full = nwg / GG, T = nwg - full * GG, nidle = T > 0 ? GG - T : GG, rank = T > 0 ? F.wgv - T : F.wgv;
        if (rank >= 0) convert_items(F, FFN_END - P0_MOVED, FFN_END, rank * NWAVES + F.wave, nidle * NWAVES); } } }
    PHASE_END(1)
    PHASE_BEGIN(2)
#pragma unroll
    for (int rp = 0; rp < 1; ++rp) { for (int m = MP + gw; m < M; m += NGW) ln_sample_row(F, m); }
#pragma unroll
    for (int rp = 0; rp < 1; ++rp) { for (int u = F.wg; u < 2 * NBH; u += F.G) { if (u < NBH) gla_prep_unit(F, u); else v_transpose_unit(F, u - NBH); } }
    PHASE_END(2)
    PHASE_BEGIN(3)
#pragma unroll
    for (int rp = 0; rp < 1; ++rp) { for (int u = F.wgv; u < NG * 32; u += F.G) chain_pass1_unit(F, u); }
    PHASE_END(3)
    PHASE_BEGIN(4)
#pragma unroll
    for (int rp = 0; rp < 1; ++rp) { for (int u = F.wgv; u < NG * 32; u += F.G) chain_pass2_prompt_unit(F, u); }
#pragma unroll
    for (int rp = 0; rp < 1; ++rp) { for (int u = F.wgv; u < 32 * 32; u += F.G) chain_sample_unit(F, u); }
    PHASE_END(4)
    PHASE_BEGIN(5)
    gla_finish_rows(F, gw, NGW);
    __syncthreads();
#pragma unroll
    for (int rp = 0; rp < 1; ++rp) { SguPre sp; SguW sw; sw.a = -1; if (F.wg < 160 * 16) sgu_prefetch(F, F.wg, sp); for (int u = F.wg; u < 160 * 16; u += F.G) sgu_unit(F, u, sp, u + F.G < 160 * 16 ? u + F.G : -1, sw); }
    PHASE_END(5)
    PHASE_BEGIN(6)
    { int rounds, T, P; pg8::split_plan((M / 256) * (DM / 256), F.G, 4, rounds, T, P);
      pg8::Gemm g{F.MIX, F.WOUT, M, DM, DM}; pg8::StaticOrder S; S.init(M, DM, F.G, F.wgv, GWGM); S.imax = rounds; pg8::EpiResidNorm E{F.x_prompt, F.x_sample, MP, F.out, F.HN, F.g_ffn, (float*)(F.ctl + CW_SSQ)};
      pg8::gemm_phase<pg8::EpiResidNorm, pg8::StaticOrder, ALIGN_P6, GEMM_SP2>(F.lds, g, S, E);
      if (T > 0) { pg8::Gemm g2{F.MIX, F.WOUT, M, DM, DM / P, DM}; pg8::TailOrder TO; TO.init(M, DM, F.G, F.wgv, GWGM); TO.base = rounds * F.G; TO.T = T; TO.P = P;
          pg8::EpiPublish E2; E2.slab = (float*)(args.ws + WS_SLAB); E2.flags = F.ctl + CW_FLAG + 4096 * 0; E2.nparts = P;
          pg8::gemm_phase<pg8::EpiPublish, pg8::TailOrder, true, GEMM_SP2>(F.lds, g2, TO, E2);
          pg8::tail_combine(TO, E, E2.slab, E2.flags, P); } }
    PHASE_END(6)
    PHASE_BEGIN(8)
    { int rounds, T, P; pg8::split_plan((M / 256) * (2 * DFF / 256), F.G, 4, rounds, T, P);
      pg8::Gemm g{F.HN, F.WGU, M, 2 * DFF, DM}; pg8::StaticOrder S; S.init(M, 2 * DFF, F.G, F.wgv, GWGM); S.imax = rounds; pg8::EpiSwiglu E{F.HFF, (const float*)(F.ctl + CW_SSQ)};
      pg8::gemm_phase<pg8::EpiSwiglu, pg8::StaticOrder, ALIGN_P8, GEMM_SP2>(F.lds, g, S, E);
      if (T > 0) { pg8::Gemm g2{F.HN, F.WGU, M, 2 * DFF, DM / P, DM}; pg8::TailOrder TO; TO.init(M, 2 * DFF, F.G, F.wgv, GWGM); TO.base = rounds * F.G; TO.T = T; TO.P = P;
          pg8::EpiPublish E2{(float*)(args.ws + WS_SLAB), F.ctl + CW_FLAG + 4096 * 1, P};
          pg8::gemm_phase<pg8::EpiPublish, pg8::TailOrder, true, GEMM_SP2>(F.lds, g2, TO, E2);
          pg8::tail_combine(TO, E, E2.slab, E2.flags, P); } }
    PHASE_END(8)
    PHASE_BEGIN(9)
    { int rounds, T, P; pg8::split_plan((M / 256) * (DM / 256), F.G, 2, rounds, T, P);
      pg8::Gemm g{F.HFF, F.WDN, M, DM, DFF}; pg8::StaticOrder S; S.init(M, DM, F.G, F.wgv, P9_WGM); S.imax = rounds; pg8::EpiResidFinal E{F.HN, F.g_ffn, (float*)(F.ctl + CW_SSQ2)};
      pg8::gemm_phase<pg8::EpiResidFinal, pg8::StaticOrder, ALIGN_P6, GEMM_SP2>(F.lds, g, S, E);
      if (T > 0) { pg8::Gemm g2{F.HFF, F.WDN, M, DM, DFF / P, DFF}; pg8::TailOrder TO; TO.init(M, DM, F.G, F.wgv, P9_WGM); TO.base = rounds * F.G; TO.T = T; TO.P = P;
          pg8::EpiPublish E2; E2.slab = (float*)(args.ws + WS_SLAB); E2.flags = F.ctl + CW_FLAG + 4096 * 2; E2.nparts = P;
          pg8::gemm_phase<pg8::EpiPublish, pg8::TailOrder, true, GEMM_SP2>(F.lds, g2, TO, E2);
          pg8::tail_combine(TO, E, E2.slab, E2.flags, P); } }
    PHASE_END(9)
    PHASE_BEGIN(10)
    final_norm_rows(F, gw, NGW);
    }
}

extern "C" void kernel_launch(void* const* d_in, const int* in_sizes, int n_in, void* d_out, int out_size, void* d_ws, size_t ws_size, hipStream_t stream) {
    static int grid = 0;
    if (grid == 0) {
        if (n_in != 18 || (size_t)out_size != O_END || ws_size < WS_END) { fprintf(stderr, "kernel_launch: unexpected shapes (n_in %d, out %d, ws %zu < %zu); nothing launched\n", n_in, out_size, ws_size, (size_t)WS_END); grid = -1; return; }
        int dev = 0, cus = 0, per_cu = 0;
        if (hipGetDevice(&dev) != hipSuccess || hipDeviceGetAttribute(&cus, hipDeviceAttributeMultiprocessorCount, dev) != hipSuccess) { grid = -1; return; }
        if (hipFuncSetAttribute((const void*)fwd_kernel, hipFuncAttributeMaxDynamicSharedMemorySize, LDS_BYTES) != hipSuccess) { fprintf(stderr, "kernel_launch: hipFuncSetAttribute failed\n"); grid = -1; return; }
        if (hipOccupancyMaxActiveBlocksPerMultiprocessor(&per_cu, (const void*)fwd_kernel, NWAVES * 64, LDS_BYTES) != hipSuccess || per_cu < 1)
            fprintf(stderr, "kernel_launch: note: occupancy query reports %d workgroups per CU\n", per_cu);
        (void)hipGetLastError();
        grid = cus;
    }
    if (grid < 0) return;
    if (hipMemsetAsync((char*)d_ws + WS_CTL, 0, CTL_ZERO_BYTES, stream) != hipSuccess) return;
    Args a{};
    for (int i = 0; i < 18; ++i) a.in[i] = (const float*)d_in[i];
    a.out = (float*)d_out; a.ws = (unsigned char*)d_ws;
    hipLaunchKernelGGL(fwd_kernel, dim3(grid), dim3(NWAVES * 64), LDS_BYTES, stream, a);
}
```

```cpp
#include <hip/hip_runtime.h>
#include <cstdio>
#include <cstdint>

namespace pg8 {
#define PG8_LAS __attribute__((address_space(3)))
typedef unsigned short bf16_t;
typedef short bf16x8 __attribute__((ext_vector_type(8)));
typedef float f32x4 __attribute__((ext_vector_type(4)));
typedef unsigned u32x4 __attribute__((ext_vector_type(4)));
typedef unsigned u32x2 __attribute__((ext_vector_type(2)));
constexpr int BM = 256, BK = 64, HALF = 128, HTB = HALF * BK * 2  , STAGE_BYTES = 8 * HTB, NXCD = 8, WGM = 8;

__host__ __device__ __forceinline__ int lds_byte(int r, int c) { const int st = (r >> 4) * 2 + (c >> 5), rr = r & 15, cc = c & 31, ob = rr * 64 + cc * 2; return st * 1024 + (ob ^ (((ob >> 9) & 1) << 5)); }
__host__ __device__ __forceinline__ void stage_rc(int b, int& R, int& C) { const int st = b / 1024, sb = b % 1024, swz = sb ^ (((sb >> 9) & 1) << 5); R = (st >> 1) * 16 + swz / 64; C = (st & 1) * 32 + (swz % 64) / 2; }
__host__ __device__ __forceinline__ int perm32(int rho) { const int n = rho >> 4, i = rho & 15; return 8 * (i >> 2) + 4 * n + (i & 3); }

struct Unit { int pm, pn, kp, tt; };
struct Gemm { const bf16_t* A; const bf16_t* Bt; int M, N, K; int ld = 0; };

struct StaticOrder {
    int nM, nN, nwg, G, c, wgm, imax;
    __host__ __device__ void init(int M, int N, int G_, int c_, int wgm_ = WGM) { nM = M / BM; nN = N / BM; nwg = nM * nN; G = G_; c = c_; wgm = wgm_; imax = 1 << 30; }
    __host__ __device__ void tile_of(long L, Unit& u) const {
        if (wgm < 0) { const int xcd = (int)(L % NXCD), off = (int)(L / NXCD), w = nN / NXCD; u.pm = off / w; u.pn = xcd * w + off % w; u.kp = 0; u.tt = 0; return; }
        int wgid = (int)L; { const int q = nwg / NXCD, r = nwg % NXCD, xcd = wgid % NXCD, off = wgid / NXCD; wgid = (xcd < r ? xcd * (q + 1) : r * (q + 1) + (xcd - r) * q) + off; }
        const int nig = wgm * nN, gid = wgid / nig, fm = gid * wgm, gsz = (nM - fm) < wgm ? (nM - fm) : wgm;
        u.pm = fm + ((wgid % nig) % gsz); u.pn = (wgid % nig) / gsz; u.kp = 0; u.tt = 0;
    }
    __host__ __device__ bool next(int i, Unit& u) const { const long L = (long)i * G + c; if (L >= nwg || i >= imax) return false; tile_of(L, u); return true; }
    __device__ __forceinline__ void a_ready(const Unit&) const {}
    __device__ __forceinline__ void done(const Unit&) const {}
};
struct TailOrder : StaticOrder {
    int base, T, P;
    __host__ __device__ bool next(int i, Unit& u) const { if (i > 0 || c >= T * P) return false; const int tt = c % T; tile_of((long)base + tt, u); u.kp = c / T; u.tt = tt; return true; }
};
__host__ __device__ __forceinline__ void split_plan(int nwg, int G, int maxP, int& rounds, int& T, int& P) { rounds = nwg / G; T = nwg - rounds * G; P = 1; if (T > 0) { const int q = G / T; P = q >= 4 ? 4 : (q >= 2 ? 2 : 1); if (P > maxP) P = maxP; } if (P < 2) { if (T > 0) ++rounds; T = 0; } }

__device__ __forceinline__ unsigned cvt_pk_bf16(float lo, float hi) { unsigned r; asm volatile("v_cvt_pk_bf16_f32 %0, %1, %2" : "=v"(r) : "v"(lo), "v"(hi)); return r; }
__device__ __forceinline__ float x_sigmoid(float x, float t) { return x * __builtin_amdgcn_rcpf(1.0f + __builtin_amdgcn_exp2f(-1.4426950408889634f * t)); }
__device__ __forceinline__ float gelu_tanh(float x) { const float u = 0.7978845608028654f * (x + 0.044715f * x * x * x); return x_sigmoid(x, 2.0f * u); }
__device__ __forceinline__ float silu_f(float x) { return x_sigmoid(x, x); }
template <int MODE> __device__ __forceinline__ float act_f(float x) { return MODE == 1 ? gelu_tanh(x) : (MODE == 2 ? x * 0.0625f : (MODE == 3 ? silu_f(x) : x)); }
__device__ __forceinline__ f32x4 x_sigmoid_v(f32x4 x, f32x4 t) {
    f32x4 e; e[0] = __builtin_amdgcn_exp2f(t[0]); e[1] = __builtin_amdgcn_exp2f(t[1]); e[2] = __builtin_amdgcn_exp2f(t[2]); e[3] = __builtin_amdgcn_exp2f(t[3]);
    const f32x4 d = e + 1.0f; f32x4 r; r[0] = __builtin_amdgcn_rcpf(d[0]); r[1] = __builtin_amdgcn_rcpf(d[1]); r[2] = __builtin_amdgcn_rcpf(d[2]); r[3] = __builtin_amdgcn_rcpf(d[3]);
    return x * r; }
template <int MODE> __device__ __forceinline__ f32x4 act_v(f32x4 x) {
    if (MODE == 1) { constexpr float K = -2.0f * 0.7978845608028654f * 1.4426950408889634f; return x_sigmoid_v(x, x * ((x * x) * (K * 0.044715f) + K)); }
    if (MODE == 3) return x_sigmoid_v(x, x * -1.4426950408889634f);
    if (MODE == 2) return x * 0.0625f;
    return x; }

struct EpiProj {
    static constexpr bool PERM = true, AFTER_DRAIN = false;
    bf16_t* P; float* glr; float* vst;
    template <int MODE, bool STATS> __device__ __forceinline__ void tile(const f32x4 (&acc)[2][2][4][2], int row0, int col0, int fq) const {
#pragma unroll
        for (int ai = 0; ai < 2; ++ai)
#pragma unroll
            for (int m = 0; m < 4; ++m) { const int row = row0 + ai * HALF + m * 16; bf16_t* rowp = P + (size_t)row * 10240 + col0; float s1 = 0.f, s2 = 0.f;
#pragma unroll
                for (int bj = 0; bj < 2; ++bj) { const f32x4 A0 = act_v<MODE>(acc[ai][bj][m][0]), A1 = act_v<MODE>(acc[ai][bj][m][1]); u32x4 w;
                    if (STATS) { const f32x4 p = A0 + A1, q = A0 * A0 + A1 * A1; s1 += (p[0] + p[1]) + (p[2] + p[3]); s2 += (q[0] + q[1]) + (q[2] + q[3]); }
                    w.x = cvt_pk_bf16(A0[0], A0[1]); w.y = cvt_pk_bf16(A0[2], A0[3]); w.z = cvt_pk_bf16(A1[0], A1[1]); w.w = cvt_pk_bf16(A1[2], A1[3]);
                    *(u32x4*)(rowp + bj * HALF) = w; }
                if (STATS) { s1 += __shfl_xor(s1, 16); s1 += __shfl_xor(s1, 32); s2 += __shfl_xor(s2, 16); s2 += __shfl_xor(s2, 32);
                    if (fq == 0) { atomicAdd(vst + 2 * row, s1); atomicAdd(vst + 2 * row + 1, s2); } } }
    }
    __device__ __forceinline__ void operator()(const f32x4 (&acc)[2][2][4][2], const Unit& u, int wr, int wc, int fr, int fq) const {
        asm volatile("s_nop 15" ::: "memory");
        const int row0 = u.pm * BM + wr * 64 + fr, colt = u.pn * BM;
        if (colt >= 10240) {
            if (wc == 0 && fq < 2) {
#pragma unroll
                for (int ai = 0; ai < 2; ++ai)
#pragma unroll
                    for (int m = 0; m < 4; ++m) { float* rp = glr + (size_t)(row0 + ai * HALF + m * 16) * 16 + 8 * fq; *(f32x4*)rp = acc[ai][0][m][0]; *(f32x4*)(rp + 4) = acc[ai][0][m][1]; }
            }
            return;
        }
        const int col0 = colt + wc * 32 + 8 * fq;
        if (colt < 2048) tile<1, false>(acc, row0, col0, fq); else if (colt < 4096) tile<1, true>(acc, row0, col0, fq); else if (colt < 5120) tile<2, false>(acc, row0, col0, fq);
        else if (colt < 8192) tile<0, false>(acc, row0, col0, fq); else tile<3, false>(acc, row0, col0, fq);
    }
};
struct EpiResidNorm {
    static constexpr bool PERM = true, AFTER_DRAIN = false;
    const float* r0; const float* r1; int split; float* out; bf16_t* hn; const float* gain; float* ssq;
    __device__ __forceinline__ void operator()(const f32x4 (&acc)[2][2][4][2], const Unit& u, int wr, int wc, int fr, int fq) const {
        const int row0 = u.pm * BM + wr * 64 + fr, col0 = u.pn * BM + wc * 32 + 8 * fq;
        const float* rb = (u.pm * BM < split) ? r0 : (r1 - (size_t)split * 4096);
        f32x4 gv[2][2];
#pragma unroll
        for (int bj = 0; bj < 2; ++bj)
#pragma unroll
            for (int n = 0; n < 2; ++n) gv[bj][n] = *(const f32x4*)(gain + col0 + bj * HALF + 4 * n);
#pragma unroll
        for (int ai = 0; ai < 2; ++ai)
#pragma unroll
          for (int mh = 0; mh < 2; ++mh) {
            f32x4 xr[2][2][2];
#pragma unroll
            for (int mm = 0; mm < 2; ++mm)
#pragma unroll
                for (int bj = 0; bj < 2; ++bj) { const float* q = rb + (size_t)(row0 + ai * HALF + (2 * mh + mm) * 16) * 4096 + col0 + bj * HALF; xr[mm][bj][0] = *(const f32x4*)q; xr[mm][bj][1] = *(const f32x4*)(q + 4); }
#pragma unroll
            for (int mm = 0; mm < 2; ++mm) { const int m = 2 * mh + mm; const int row = row0 + ai * HALF + m * 16; const size_t off = (size_t)row * 4096 + col0; float s = 0.f;
#pragma unroll
                for (int bj = 0; bj < 2; ++bj) { const f32x4 a0 = xr[mm][bj][0] + acc[ai][bj][m][0], a1 = xr[mm][bj][1] + acc[ai][bj][m][1];
                    s += ((a0[0] * a0[0] + a0[1] * a0[1]) + (a0[2] * a0[2] + a0[3] * a0[3])) + ((a1[0] * a1[0] + a1[1] * a1[1]) + (a1[2] * a1[2] + a1[3] * a1[3]));
                    const f32x4 y0 = a0 * gv[bj][0], y1 = a1 * gv[bj][1]; u32x4 w; w.x = cvt_pk_bf16(y0[0], y0[1]); w.y = cvt_pk_bf16(y0[2], y0[3]); w.z = cvt_pk_bf16(y1[0], y1[1]); w.w = cvt_pk_bf16(y1[2], y1[3]);
                    *(u32x4*)(hn + off + bj * HALF) = w; }
                s += __shfl_xor(s, 16); s += __shfl_xor(s, 32);
                if (fq == 0) atomicAdd(ssq + row, s); }
            asm volatile("" ::: "memory"); }
    }
};
struct EpiResidFinal {
    static constexpr bool PERM = true, AFTER_DRAIN = false;
    bf16_t* x2; const float* gain; float* ssq;
    __device__ __forceinline__ void operator()(const f32x4 (&acc)[2][2][4][2], const Unit& u, int wr, int wc, int fr, int fq) const {
        const int row0 = u.pm * BM + wr * 64 + fr, col0 = u.pn * BM + wc * 32 + 8 * fq;
        f32x4 rg[2][2];
#pragma unroll
        for (int bj = 0; bj < 2; ++bj)
#pragma unroll
            for (int n = 0; n < 2; ++n) { const f32x4 gvv = *(const f32x4*)(gain + col0 + bj * HALF + 4 * n); rg[bj][n][0] = 1.0f / gvv[0]; rg[bj][n][1] = 1.0f / gvv[1]; rg[bj][n][2] = 1.0f / gvv[2]; rg[bj][n][3] = 1.0f / gvv[3]; }
#pragma unroll
        for (int ai = 0; ai < 2; ++ai) {
            u32x4 hw[4][2];
#pragma unroll
            for (int m = 0; m < 4; ++m)
#pragma unroll
                for (int bj = 0; bj < 2; ++bj) hw[m][bj] = *(const u32x4*)(x2 + (size_t)(row0 + ai * HALF + m * 16) * 4096 + col0 + bj * HALF);
#pragma unroll
            for (int m = 0; m < 4; ++m) { const int row = row0 + ai * HALF + m * 16; const size_t off = (size_t)row * 4096 + col0; float s = 0.f;
#pragma unroll
                for (int bj = 0; bj < 2; ++bj) { const u32x4 h = hw[m][bj];
                    f32x4 v0, v1; v0[0] = __builtin_bit_cast(float, h.x << 16); v0[1] = __builtin_bit_cast(float, h.x & 0xffff0000u); v0[2] = __builtin_bit_cast(float, h.y << 16); v0[3] = __builtin_bit_cast(float, h.y & 0xffff0000u);
                    v1[0] = __builtin_bit_cast(float, h.z << 16); v1[1] = __builtin_bit_cast(float, h.z & 0xffff0000u); v1[2] = __builtin_bit_cast(float, h.w << 16); v1[3] = __builtin_bit_cast(float, h.w & 0xffff0000u);
                    v0 = v0 * rg[bj][0] + acc[ai][bj][m][0]; v1 = v1 * rg[bj][1] + acc[ai][bj][m][1];
                    s += ((v0[0] * v0[0] + v0[1] * v0[1]) + (v0[2] * v0[2] + v0[3] * v0[3])) + ((v1[0] * v1[0] + v1[1] * v1[1]) + (v1[2] * v1[2] + v1[3] * v1[3]));
                    u32x4 w; w.x = cvt_pk_bf16(v0[0], v0[1]); w.y = cvt_pk_bf16(v0[2], v0[3]); w.z = cvt_pk_bf16(v1[0], v1[1]); w.w = cvt_pk_bf16(v1[2], v1[3]); *(u32x4*)(x2 + off + bj * HALF) = w; }
                s += __shfl_xor(s, 16); s += __shfl_xor(s, 32);
                if (fq == 0) atomicAdd(ssq + row, s); }
            asm volatile("" ::: "memory"); }
    }
};
struct EpiSwiglu {
    static constexpr bool PERM = true, AFTER_DRAIN = false;
    bf16_t* H; const float* ssq;
    __device__ __forceinline__ void operator()(const f32x4 (&acc)[2][2][4][2], const Unit& u, int wr, int wc, int fr, int fq) const {
        const int row0 = u.pm * BM + wr * 64 + fr, col0 = u.pn * HALF + wc * 32 + 8 * fq;
        float rsv[2][4];
#pragma unroll
        for (int ai = 0; ai < 2; ++ai)
#pragma unroll
            for (int m = 0; m < 4; ++m) rsv[ai][m] = ssq[row0 + ai * HALF + m * 16];
#pragma unroll
        for (int ai = 0; ai < 2; ++ai)
#pragma unroll
            for (int m = 0; m < 4; ++m) rsv[ai][m] = __builtin_amdgcn_rsqf(rsv[ai][m] * (1.f / 4096.f) + 1e-6f);
#pragma unroll
        for (int ai = 0; ai < 2; ++ai)
#pragma unroll
            for (int m = 0; m < 4; ++m) { const int row = row0 + ai * HALF + m * 16; const float rs = rsv[ai][m];
                const float rl = rs * -1.4426950408889634f, rq = rs * rs; u32x4 w;
                const f32x4 o0 = x_sigmoid_v(acc[ai][0][m][0] * acc[ai][1][m][0] * rq, acc[ai][0][m][0] * rl), o1 = x_sigmoid_v(acc[ai][0][m][1] * acc[ai][1][m][1] * rq, acc[ai][0][m][1] * rl);
                w.x = cvt_pk_bf16(o0[0], o0[1]); w.y = cvt_pk_bf16(o0[2], o0[3]); w.z = cvt_pk_bf16(o1[0], o1[1]); w.w = cvt_pk_bf16(o1[2], o1[3]);
                *(u32x4*)(H + (size_t)row * 11008 + col0) = w; }
    }
};

struct EpiPublish {
    static constexpr bool PERM = true, AFTER_DRAIN = false;
    float* slab; unsigned* flags; int nparts;
    __device__ __forceinline__ void operator()(const f32x4 (&acc)[2][2][4][2], const Unit& u, int wr, int wc, int fr, int fq) const {
        asm volatile("s_nop 15" ::: "memory");
        const int wid = wr * 4 + wc, lane = fq * 16 + fr;
        const __amdgpu_buffer_rsrc_t rs = __builtin_amdgcn_make_buffer_rsrc((void*)slab, (short)0, 0x7fffffff, 0x00020000);
        const unsigned off0 = ((unsigned)((u.tt * nparts + u.kp) * 8 + wid) * 16u * 64u + (unsigned)lane) * 16u;
#pragma unroll
        for (int ai = 0; ai < 2; ++ai)
#pragma unroll
            for (int bj = 0; bj < 2; ++bj)
#pragma unroll
                for (int m = 0; m < 4; ++m) { const int q = (ai * 2 + bj) * 4 + m; const f32x4 v0 = acc[ai][bj][m][0], v1 = acc[ai][bj][m][1]; u32x4 w;
                    w.x = cvt_pk_bf16(v0[0], v0[1]); w.y = cvt_pk_bf16(v0[2], v0[3]); w.z = cvt_pk_bf16(v1[0], v1[1]); w.w = cvt_pk_bf16(v1[2], v1[3]);
                    __builtin_amdgcn_raw_buffer_store_b128(w, rs, (int)(off0 + (unsigned)q * 1024u), 0, 16); }
        asm volatile("s_waitcnt vmcnt(0)" ::: "memory");
        if (lane == 0) __hip_atomic_fetch_add(flags + 16 * u.tt, 1u, __ATOMIC_RELAXED, __HIP_MEMORY_SCOPE_AGENT);
    }
};
struct EpiPublishNP : EpiPublish { static constexpr bool PERM = false; };
template <class Base> __device__ __forceinline__ void tail_combine(const TailOrder& TO, const Base& E, const float* slab, unsigned* flags, int nparts) {
    Unit u; if (!TO.next(0, u) || u.kp != 0) return;
    int tid_ = threadIdx.x; asm volatile("" : "+v"(tid_));
    const int wid = __builtin_amdgcn_readfirstlane(tid_ >> 6), lane = tid_ & 63, wr = wid >> 2, wc = wid & 3, fr = lane & 15, fq = lane >> 4;
    { unsigned* flag = flags + 16 * u.tt; const unsigned want = 8u * (unsigned)nparts; unsigned spins = 0;
      while ((unsigned)__builtin_amdgcn_readfirstlane(__hip_atomic_load(flag, __ATOMIC_RELAXED, __HIP_MEMORY_SCOPE_AGENT)) < want) { __builtin_amdgcn_s_sleep(2); if (++spins > (1u << 22)) break; }
      __builtin_amdgcn_fence(__ATOMIC_ACQUIRE, "agent"); asm volatile("s_waitcnt vmcnt(0)" ::: "memory"); }
    f32x4 acc[2][2][4][2];
#pragma unroll
    for (int ai = 0; ai < 2; ++ai)
#pragma unroll
        for (int bj = 0; bj < 2; ++bj)
#pragma unroll
            for (int m = 0; m < 4; ++m)
#pragma unroll
                for (int n = 0; n < 2; ++n) acc[ai][bj][m][n] = (f32x4){0.f, 0.f, 0.f, 0.f};
    for (int p = 0; p < nparts; ++p) {
        const u32x4* src = (const u32x4*)slab + ((size_t)((u.tt * nparts + p) * 8 + wid) * 16) * 64 + lane;
#pragma unroll
        for (int ai = 0; ai < 2; ++ai)
#pragma unroll
            for (int bj = 0; bj < 2; ++bj) {
#pragma unroll
                for (int m = 0; m < 4; ++m) { const int q = (ai * 2 + bj) * 4 + m; const u32x4 w = src[(size_t)q * 64]; f32x4 v0, v1;
                    v0[0] = __builtin_bit_cast(float, w.x << 16); v0[1] = __builtin_bit_cast(float, w.x & 0xffff0000u); v0[2] = __builtin_bit_cast(float, w.y << 16); v0[3] = __builtin_bit_cast(float, w.y & 0xffff0000u);
                    v1[0] = __builtin_bit_cast(float, w.z << 16); v1[1] = __builtin_bit_cast(float, w.z & 0xffff0000u); v1[2] = __builtin_bit_cast(float, w.w << 16); v1[3] = __builtin_bit_cast(float, w.w & 0xffff0000u);
                    acc[ai][bj][m][0] += v0; acc[ai][bj][m][1] += v1; }
                asm volatile("" ::: "memory"); }
    }
    E(acc, u, wr, wc, fr, fq);
}
template <class Epi, class Sched, bool ALIGN_EPI = false, bool SP2 = false>
__device__ __forceinline__ void gemm_phase(PG8_LAS unsigned char* lds, const Gemm g, const Sched& S, const Epi& E) {
    int tid_ = threadIdx.x; asm volatile("" : "+v"(tid_));
    const int tid = tid_, wid = __builtin_amdgcn_readfirstlane(tid >> 6), lane = tid & 63, wr = wid >> 2, wc = wid & 3, fr = lane & 15, fq = lane >> 4;
    const int K = g.K, nt = K / BK, LD = g.ld ? g.ld : g.K;
    unsigned voffA[2], voffB[2];
#pragma unroll
    for (int i = 0; i < 2; ++i) { int R, C; stage_rc(tid * 16 + i * 8192, R, C); const int Rb = Epi::PERM ? ((R & ~31) + perm32(R & 31)) : R;
        voffA[i] = (unsigned)(R * LD + C) * 2u; voffB[i] = (unsigned)(Rb * LD + C) * 2u; }
    const size_t kstep = (size_t)(BK * 2);
    const size_t hstep = (size_t)HALF * LD * 2;
    const size_t tstep = 2 * hstep;
    const unsigned ldsw = (unsigned)wid * 1024u;
    const int aoff = lds_byte(wr * 64 + fr, fq * 8), boff = lds_byte(wc * 32 + fr, fq * 8);
#define PG8_SA(b, h) (((b) * 2 + (h)) * HTB)
#define PG8_SB(b, h) ((4 + (b) * 2 + (h)) * HTB)
#define PG8_STAGE(bufoff, gbase, voff) do { _Pragma("unroll") for (int _i = 0; _i < 2; ++_i) \
        __builtin_amdgcn_global_load_lds((const unsigned*)((const char*)(gbase) + (voff)[_i]), (PG8_LAS unsigned*)(lds + (bufoff) + ldsw + _i * 8192), 16, 0, 0); } while (0)
#define PG8_LDA(dst, b, h) do { _Pragma("unroll") for (int m = 0; m < 4; ++m) _Pragma("unroll") for (int k = 0; k < 2; ++k) dst[m][k] = *(const PG8_LAS bf16x8*)(lds + PG8_SA(b, h) + aoff + m * 2048 + k * 1024); } while (0)
#define PG8_LDB(dst, b, h) do { _Pragma("unroll") for (int n = 0; n < 2; ++n) _Pragma("unroll") for (int k = 0; k < 2; ++k) dst[n][k] = *(const PG8_LAS bf16x8*)(lds + PG8_SB(b, h) + boff + n * 2048 + k * 1024); } while (0)
#define PG8_MMA(ai, bj, At, Bt) do { __builtin_amdgcn_s_setprio(1); _Pragma("unroll") for (int m = 0; m < 4; ++m) _Pragma("unroll") for (int n = 0; n < 2; ++n) _Pragma("unroll") for (int k = 0; k < 2; ++k) \
        acc[ai][bj][m][n] = __builtin_amdgcn_mfma_f32_16x16x32_bf16(Bt[n][k], At[m][k], acc[ai][bj][m][n], 0, 0, 0); __builtin_amdgcn_s_setprio(0); } while (0)
#define PG8_WAIT_V(n) asm volatile("s_waitcnt vmcnt(" #n ")" ::: "memory")
#define PG8_WAIT_L(n) asm volatile("s_waitcnt lgkmcnt(" #n ")" ::: "memory")
#define PG8_BAR __builtin_amdgcn_s_barrier()
#define PG8_SCHED __builtin_amdgcn_sched_barrier(0)
    Unit cur, nxt; int ui = 0;
    if (!S.next(0, cur)) return;
    f32x4 acc[2][2][4][2];
#pragma unroll
    for (int a = 0; a < 2; ++a)
#pragma unroll
        for (int b = 0; b < 2; ++b)
#pragma unroll
            for (int m = 0; m < 4; ++m)
#pragma unroll
                for (int n = 0; n < 2; ++n) acc[a][b][m][n] = (f32x4){0.f, 0.f, 0.f, 0.f};
    bf16x8 At[4][2], B0[2][2], B1[2][2];
    const char* cA = (const char*)g.A + (size_t)cur.pm * tstep + (size_t)cur.kp * K * 2; const char* cB = (const char*)g.Bt + (size_t)cur.pn * tstep + (size_t)cur.kp * K * 2;
    S.a_ready(cur);
    if constexpr (SP2) {
        PG8_STAGE(PG8_SB(0, 0), cB, voffB); PG8_STAGE(PG8_SB(0, 1), cB + hstep, voffB); PG8_STAGE(PG8_SA(0, 0), cA, voffA); PG8_STAGE(PG8_SA(0, 1), cA + hstep, voffA);
        if (wr == 1) PG8_BAR;
        PG8_WAIT_V(2); PG8_BAR;
        PG8_STAGE(PG8_SB(1, 0), cB + kstep, voffB); PG8_STAGE(PG8_SA(1, 0), cA + kstep, voffA); PG8_STAGE(PG8_SB(1, 1), cB + hstep + kstep, voffB);
        PG8_WAIT_V(6); PG8_BAR;
    } else {
        PG8_STAGE(PG8_SB(0, 0), cB, voffB); PG8_STAGE(PG8_SA(0, 0), cA, voffA); PG8_STAGE(PG8_SB(0, 1), cB + hstep, voffB); PG8_STAGE(PG8_SA(0, 1), cA + hstep, voffA);
        if (wr == 1) PG8_BAR;
        PG8_WAIT_V(4); PG8_BAR;
        PG8_STAGE(PG8_SB(1, 0), cB + kstep, voffB); PG8_STAGE(PG8_SA(1, 0), cA + kstep, voffA); PG8_STAGE(PG8_SB(1, 1), cB + hstep + kstep, voffB);
        PG8_WAIT_V(6); PG8_BAR;
    }
    for (;;) {
        const bool has_next = S.next(ui + 1, nxt);
        const char* nA = has_next ? (const char*)g.A + (size_t)nxt.pm * tstep + (size_t)nxt.kp * K * 2 : cA; const char* nB = has_next ? (const char*)g.Bt + (size_t)nxt.pn * tstep + (size_t)nxt.kp * K * 2 : cB;
        for (int t = 0; t < nt; t += 2) {
            const bool last = (t == nt - 2);
            const char* a1 = cA + (size_t)(t + 1) * kstep;
            const char* a2 = last ? nA : cA + (size_t)(t + 2) * kstep; const char* b2 = last ? nB : cB + (size_t)(t + 2) * kstep;
            const char* a3 = a2 + kstep; const char* b3 = b2 + kstep;
            if (last && has_next) S.a_ready(nxt);
            if constexpr (SP2) {
            PG8_LDB(B0, 0, 0); PG8_LDB(B1, 0, 1); PG8_SCHED; PG8_LDA(At, 0, 0); PG8_STAGE(PG8_SA(1, 1), a1 + hstep, voffA);
            PG8_WAIT_V(8); PG8_WAIT_L(0); PG8_BAR; PG8_MMA(0, 0, At, B0); PG8_MMA(0, 1, At, B1); PG8_BAR; PG8_SCHED;
            PG8_LDA(At, 0, 1); PG8_STAGE(PG8_SB(0, 0), b2, voffB); PG8_STAGE(PG8_SB(0, 1), b2 + hstep, voffB); PG8_STAGE(PG8_SA(0, 0), a2, voffA);
            PG8_WAIT_V(8); PG8_WAIT_L(0); PG8_BAR; PG8_MMA(1, 0, At, B0); PG8_MMA(1, 1, At, B1); PG8_BAR; PG8_SCHED;
            PG8_LDB(B0, 1, 0); PG8_LDB(B1, 1, 1); PG8_SCHED; PG8_LDA(At, 1, 0); PG8_STAGE(PG8_SA(0, 1), a2 + hstep, voffA);
            PG8_WAIT_V(8); PG8_WAIT_L(0); PG8_BAR; PG8_MMA(0, 0, At, B0); PG8_MMA(0, 1, At, B1); PG8_BAR; PG8_SCHED;
            PG8_LDA(At, 1, 1); PG8_STAGE(PG8_SB(1, 0), b3, voffB); PG8_STAGE(PG8_SB(1, 1), b3 + hstep, voffB); PG8_STAGE(PG8_SA(1, 0), a3, voffA);
            PG8_WAIT_V(8); PG8_WAIT_L(0); PG8_BAR; PG8_MMA(1, 0, At, B0); PG8_MMA(1, 1, At, B1); PG8_BAR; PG8_SCHED;
            } else {
            PG8_LDB(B0, 0, 0); PG8_SCHED; PG8_LDA(At, 0, 0); PG8_STAGE(PG8_SA(1, 1), a1 + hstep, voffA);
            PG8_WAIT_L(8); PG8_BAR; PG8_WAIT_L(0); PG8_MMA(0, 0, At, B0); PG8_BAR; PG8_SCHED;
            PG8_LDB(B1, 0, 1); PG8_STAGE(PG8_SB(0, 0), b2, voffB);
            PG8_BAR; PG8_WAIT_L(0); PG8_MMA(0, 1, At, B1); PG8_BAR;
            PG8_LDA(At, 0, 1); PG8_STAGE(PG8_SA(0, 0), a2, voffA);
            PG8_BAR; PG8_WAIT_L(0); PG8_MMA(1, 0, At, B0); PG8_BAR; PG8_SCHED;
            PG8_STAGE(PG8_SB(0, 1), b2 + hstep, voffB);
            PG8_WAIT_V(6); PG8_BAR; PG8_MMA(1, 1, At, B1); PG8_BAR;
            PG8_LDB(B0, 1, 0); PG8_SCHED; PG8_LDA(At, 1, 0); PG8_STAGE(PG8_SA(0, 1), a2 + hstep, voffA);
            PG8_WAIT_L(8); PG8_BAR; PG8_WAIT_L(0); PG8_MMA(0, 0, At, B0); PG8_BAR; PG8_SCHED;
            PG8_LDB(B1, 1, 1); PG8_STAGE(PG8_SB(1, 0), b3, voffB);
            PG8_BAR; PG8_WAIT_L(0); PG8_MMA(0, 1, At, B1); PG8_BAR;
            PG8_LDA(At, 1, 1); PG8_STAGE(PG8_SA(1, 0), a3, voffA);
            PG8_BAR; PG8_WAIT_L(0); PG8_MMA(1, 0, At, B0); PG8_BAR; PG8_SCHED;
            PG8_STAGE(PG8_SB(1, 1), b3 + hstep, voffB);
            PG8_WAIT_V(6); PG8_BAR; PG8_MMA(1, 1, At, B1); PG8_BAR;
            }
        }
        if constexpr (ALIGN_EPI) { if (wr == 0) PG8_BAR; }
        if constexpr (!Epi::AFTER_DRAIN) { E(acc, cur, wr, wc, fr, fq); S.done(cur); }
        if (!has_next) break;
#pragma unroll
        for (int a = 0; a < 2; ++a)
#pragma unroll
            for (int b = 0; b < 2; ++b)
#pragma unroll
                for (int m = 0; m < 4; ++m)
#pragma unroll
                    for (int n = 0; n < 2; ++n) acc[a][b][m][n] = (f32x4){0.f, 0.f, 0.f, 0.f};
        cur = nxt; cA = nA; cB = nB; ++ui;
        if constexpr (ALIGN_EPI) { if (wr == 1) PG8_BAR; }
    }
    PG8_WAIT_V(0);
    if constexpr (!ALIGN_EPI) { if (wr == 0) PG8_BAR; }
    PG8_BAR;
    if constexpr (Epi::AFTER_DRAIN) { E.fused(acc, cur, wr, wc, fr, fq, lds, wid, lane); S.done(cur); }
#undef PG8_SA
#undef PG8_SB
#undef PG8_STAGE
#undef PG8_LDA
#undef PG8_LDB
#undef PG8_MMA
#undef PG8_WAIT_V
#undef PG8_WAIT_L
#undef PG8_BAR
#undef PG8_SCHED
}
}

constexpr int NWAVES = 8;
constexpr int DM = 4096, MP = 16384, MS = 2048, M = MP + MS;
constexpr int AWID = 2048, AHD = 128, HK = 256, HV = 512, NHB = 4, DFF = 11008;
constexpr int INC = 10256, NPROJ = 10240, NPAD = 10496;
constexpr int C_U = 0, C_V = 2048, C_Q = 4096, C_K = 5120, C_VV = 6144, C_R = 8192;
constexpr int NBLK = M / 64, NBH = NBLK * NHB;
constexpr int NG = 8, GB = 32;
constexpr float EPS = 1e-6f;
constexpr size_t O_Y = 0, O_GP = (size_t)M * DM, O_GS = O_GP + (size_t)NHB * HK * HV, O_SV = O_GS + (size_t)32 * NHB * HK * HV, O_END = O_SV + (size_t)MS * AWID;
static_assert(O_END == 96993280, "output size");

constexpr size_t WS_CTL = 0, CTL_ZERO_BYTES = 1u << 20;
constexpr size_t WS_WIN = CTL_ZERO_BYTES;
constexpr size_t WS_WOUT = WS_WIN + (size_t)NPAD * DM * 2;
constexpr size_t WS_WGU = WS_WOUT + (size_t)DM * DM * 2;
constexpr size_t WS_WDN = WS_WGU + (size_t)2 * DFF * DM * 2;
constexpr size_t WS_HN = WS_WDN + (size_t)DM * DFF * 2;
constexpr size_t WS_PROJ = WS_HN + (size_t)M * DM * 2;
constexpr size_t WS_MIX = WS_PROJ + (size_t)M * NPROJ * 2;
constexpr size_t WS_QE = WS_MIX + (size_t)M * DM * 2;
constexpr size_t WS_GLR = WS_QE + (size_t)M * 1024 * 2;
constexpr size_t WS_STATS = WS_GLR + (size_t)M * 16 * 4;
constexpr size_t WS_BLAST = WS_STATS + (size_t)M * 2 * 4;
constexpr size_t WS_LST = WS_BLAST + (size_t)NBH * HK * 4;
constexpr size_t WS_GDEC = WS_LST + (size_t)NG * NHB * HK * HV * 4;
constexpr size_t WS_END = WS_GDEC + (size_t)NG * NHB * HK * 4;
constexpr size_t WS_KLT = WS_HN;
constexpr size_t WS_ATT = WS_KLT + (size_t)NBH * HK * 64 * 2;
constexpr size_t WS_VT = WS_ATT + (size_t)NBH * 64 * 64 * 2;
static_assert(WS_VT + (size_t)NBH * HV * 64 * 2 <= WS_PROJ, "GLA block operands overlay HN");
constexpr size_t WS_O = WS_WIN;
static_assert((size_t)M * 2048 * 2 <= (size_t)NPAD * DM * 2, "O overlays WIN");
constexpr size_t WS_SLAB = WS_WIN;
static_assert((size_t)144 * 262144 <= (size_t)NPAD * DM * 2, "slabs overlay WIN");
constexpr size_t WS_HFF = WS_PROJ;
static_assert(WS_HFF + (size_t)M * DFF * 2 <= WS_QE, "HFF overlays PROJ|MIX");
static_assert(WS_END <= 1146501120ull, "workspace budget = sum of the inputs");
constexpr int CW_BAR = 4096;
constexpr int CW_SSQ = 32768;
constexpr int CW_SSQ2 = 65536;
constexpr int CW_VST = 131072;
constexpr int CW_FLAG = 98304;
constexpr int CW_XRANK = 12288;

constexpr int RING_BYTES = 131072, PHASE_LDS = 139264, MISC_OFF = PHASE_LDS + 320, LDS_BYTES = 147456;

#define GAS __attribute__((address_space(1)))
#define LAS __attribute__((address_space(3)))
typedef unsigned short bf16;
typedef unsigned v4u __attribute__((ext_vector_type(4)));
typedef unsigned v2u __attribute__((ext_vector_type(2)));
typedef float f32x4 __attribute__((ext_vector_type(4)));
typedef short bf16x8 __attribute__((ext_vector_type(8)));
#define LDS_WAIT() asm volatile("s_waitcnt lgkmcnt(0)" ::: "memory")
#define LDS_BARRIER() asm volatile("s_waitcnt lgkmcnt(0)\n\ts_barrier" ::: "memory")
#define MFMA16(a, b, c) __builtin_amdgcn_mfma_f32_16x16x32_bf16((a), (b), (c), 0, 0, 0)
__device__ __forceinline__ unsigned f2bf(float f) { unsigned u = __builtin_bit_cast(unsigned, f); return (u + 0x7fffu + ((u >> 16) & 1u)) >> 16; }
__device__ __forceinline__ unsigned pk2(float lo, float hi) { return f2bf(lo) | (f2bf(hi) << 16); }
__device__ __forceinline__ unsigned pk2hw(float lo, float hi) { unsigned r; asm("v_cvt_pk_bf16_f32 %0, %1, %2" : "=v"(r) : "v"(lo), "v"(hi)); return r; }
__device__ __forceinline__ float bflo(unsigned w) { return __builtin_bit_cast(float, w << 16); }
__device__ __forceinline__ float bfhi(unsigned w) { return __builtin_bit_cast(float, w & 0xffff0000u); }
__device__ __forceinline__ float bf2f(bf16 b) { return __builtin_bit_cast(float, (unsigned)b << 16); }

#define XB_TMO      128
#define XB_XCNT(j)  (256  + 64 * (j))
#define XB_XSUB(j)  (1280 + 64 * (j))
#define XB_XGEN(j)  (2304 + 64 * (j))
#define XB_TOP      3328
#define XB_TOPGEN   3392
#define XCD_BAR_WORDS 3456
#define XB_SPIN_CAP (1u << 18)

__device__ __forceinline__ unsigned xb_ld(unsigned* p)              { return __hip_atomic_load(p, __ATOMIC_RELAXED, __HIP_MEMORY_SCOPE_AGENT); }
__device__ __forceinline__ unsigned xb_add(unsigned* p, unsigned v) { return __hip_atomic_fetch_add(p, v, __ATOMIC_RELAXED, __HIP_MEMORY_SCOPE_AGENT); }
__device__ __forceinline__ unsigned xb_xcc_id() { return (unsigned)__builtin_amdgcn_s_getreg((3 << 11) | 20) & 0xFu; }
#define XB_SPIN(cond, bar) do { unsigned _sp = 0; while (cond) { __builtin_amdgcn_s_sleep(1); \
    if ((++_sp & 255u) == 0u) { if (xb_ld(&(bar)[XB_TMO])) break; if (_sp > XB_SPIN_CAP) { atomicAdd(&(bar)[XB_TMO], 1u); break; } } } } while (0)

struct XcdBarrier {
    unsigned* bar; unsigned x;
    volatile LAS unsigned* st;
};

__device__ __forceinline__ XcdBarrier xcd_barrier_post(unsigned* bar, volatile LAS unsigned* st) {
    XcdBarrier b; b.bar = bar; b.x = xb_xcc_id(); b.st = st;
    if (threadIdx.x == 0) (void)xb_add(&bar[XB_XCNT(b.x)], 1u);
    return b;
}
__device__ __forceinline__ void xcd_barrier_complete(unsigned* bar, unsigned x, unsigned& nloc, unsigned& nx) {
    const unsigned G = gridDim.x * gridDim.y * gridDim.z;
    unsigned sum, cnt, mine, sp = 0u;
    for (;;) {
        sum = 0u; cnt = 0u; mine = 0u;
#pragma unroll
        for (unsigned j = 0; j < 16; ++j) { const unsigned c = xb_ld(&bar[XB_XCNT(j)]); sum += c; cnt += (c > 0u) ? 1u : 0u; mine = (j == x) ? c : mine; }
        if (sum == G) break;
        __builtin_amdgcn_s_sleep(1);
        if ((++sp & 255u) == 0u) { if (xb_ld(&bar[XB_TMO])) break; if (sp > XB_SPIN_CAP) { atomicAdd(&bar[XB_TMO], 1u); break; } }
    }
    nloc = mine > 0u ? mine : 1u; nx = cnt > 0u ? cnt : 1u;
}

__device__ __forceinline__ void xcd_barrier(const XcdBarrier& b) {
    asm volatile("s_waitcnt vmcnt(0)" ::: "memory");
    __syncthreads();
    if (threadIdx.x == 0) {
        unsigned* bar = b.bar;
        __builtin_amdgcn_s_waitcnt(0);
        unsigned nloc = b.st[0], nx = b.st[1];
        if (nloc == 0u) { xcd_barrier_complete(bar, b.x, nloc, nx); b.st[0] = nloc; b.st[1] = nx; }
        const unsigned old = xb_add(&bar[XB_XSUB(b.x)], 1u);
        const unsigned gen = old / nloc;
        if (old + 1u == (gen + 1u) * nloc) {
            __builtin_amdgcn_fence(__ATOMIC_RELEASE, "agent");
            asm volatile("s_waitcnt vmcnt(0)" ::: "memory");
            const unsigned og = xb_add(&bar[XB_TOP], 1u);
            const unsigned tg = og / nx;
            if (og + 1u == (tg + 1u) * nx) xb_add(&bar[XB_TOPGEN], 1u);
            else XB_SPIN(xb_ld(&bar[XB_TOPGEN]) == tg, bar);
            __builtin_amdgcn_fence(__ATOMIC_ACQUIRE, "agent");
            xb_add(&bar[XB_XGEN(b.x)], 1u);
            asm volatile("s_waitcnt vmcnt(0)" ::: "memory");
        } else {
            XB_SPIN(xb_ld(&bar[XB_XGEN(b.x)]) == gen, bar);
            __builtin_amdgcn_fence(__ATOMIC_ACQUIRE, "agent");
            asm volatile("s_waitcnt vmcnt(0)" ::: "memory");
        }
    }
    __syncthreads();
}
struct Frame {
    LAS unsigned char* lds;
    unsigned* ctl;
    int tid, lane, wave, G, wg, wgv;
    const float *x_prompt, *x_sample, *state_gla, *g_mix, *w_in, *w_s, *b_s, *ln_g, *ln_b, *w_gate_up, *b_gate, *gla_norm_g, *w_out, *g_ffn, *w_ffn_gate, *w_ffn_up, *w_ffn_down, *g_final;
    float* out;
    bf16 *WIN, *WOUT, *WGU, *WDN, *HN, *PROJ, *MIX, *QE, *KLT, *ATT, *VT, *O, *HFF;
    float *GLR, *STATS, *BLAST, *LST, *GDEC;
};
__device__ __forceinline__ const float* x_row(const Frame& F, int m) { return m < MP ? F.x_prompt + (size_t)m * DM : F.x_sample + (size_t)(m - MP) * DM; }
__device__ __forceinline__ float wave_sum(float v) {
#pragma unroll
    for (int o = 1; o < 64; o <<= 1) v += __shfl_xor(v, o);
    return v;
}

__device__ __forceinline__ void transpose_item(const float* W, int ldw, int K, int k0, int n0, int nvalid, bf16* WTrow0, LAS float* scr, int lane) {
    const float* src = W + (size_t)k0 * ldw + n0 + lane; const bool ok = lane < nvalid;
    float v[64];
#pragma unroll
    for (int kk = 0; kk < 64; ++kk) v[kk] = ok ? src[(size_t)kk * ldw] : 0.f;
#pragma unroll
    for (int kk = 0; kk < 64; ++kk) scr[kk * 65 + lane] = v[kk];
    LDS_WAIT(); asm volatile("" ::: "memory");
    const int c8 = lane & 7;
#pragma unroll
    for (int j = 0; j < 8; ++j) { const int n = (lane >> 3) + 8 * j; const LAS float* s = scr + (8 * c8) * 65 + n;
        v4u o; o.x = pk2hw(s[0 * 65], s[1 * 65]); o.y = pk2hw(s[2 * 65], s[3 * 65]); o.z = pk2hw(s[4 * 65], s[5 * 65]); o.w = pk2hw(s[6 * 65], s[7 * 65]);
        if (n < nvalid || nvalid >= 32) *(GAS v4u*)(WTrow0 + (size_t)n * K + k0 + 8 * c8) = o; }
    LDS_WAIT(); asm volatile("" ::: "memory");
}
struct RowGain { f32x4 g0[8], g1[8]; };
__device__ __forceinline__ void row_gain_load(const float* gain, int lane, RowGain& G) {
    const GAS f32x4* gr = (const GAS f32x4*)gain + 2 * lane;
#pragma unroll
    for (int j = 0; j < 8; ++j) { G.g0[j] = gr[128 * j]; G.g1[j] = gr[128 * j + 1]; }
}
__device__ __forceinline__ void rms_row_to_bf16(const float* xrow, const RowGain& G, bf16* orow, int lane) {
    const GAS f32x4* xr = (const GAS f32x4*)xrow + 2 * lane;
    f32x4 v[8][2]; float s = 0.f;
#pragma unroll
    for (int j = 0; j < 8; ++j) { v[j][0] = xr[128 * j]; v[j][1] = xr[128 * j + 1];
        s += ((v[j][0].x * v[j][0].x + v[j][0].y * v[j][0].y) + (v[j][0].z * v[j][0].z + v[j][0].w * v[j][0].w)) + ((v[j][1].x * v[j][1].x + v[j][1].y * v[j][1].y) + (v[j][1].z * v[j][1].z + v[j][1].w * v[j][1].w)); }
    const float rstd = 1.0f / sqrtf(wave_sum(s) * (1.f / DM) + EPS);
    GAS v4u* o16 = (GAS v4u*)orow + lane;
#pragma unroll
    for (int j = 0; j < 8; ++j) { const f32x4 g0 = G.g0[j], g1 = G.g1[j]; v4u w;
        w.x = pk2hw(v[j][0].x * rstd * g0.x, v[j][0].y * rstd * g0.y); w.y = pk2hw(v[j][0].z * rstd * g0.z, v[j][0].w * rstd * g0.w);
        w.z = pk2hw(v[j][1].x * rstd * g1.x, v[j][1].y * rstd * g1.y); w.w = pk2hw(v[j][1].z * rstd * g1.z, v[j][1].w * rstd * g1.w); o16[64 * j] = w; }
}
constexpr int P0_NB_IN = (INC + 63) / 64;
constexpr int P0_I_IN = 64 * P0_NB_IN, P0_I_OUT = 64 * 64, P0_I_G = 64 * (DFF / 64), P0_I_D = (DFF / 64) * 64, P0_NITEMS = P0_I_IN + P0_I_OUT + 2 * P0_I_G + P0_I_D;
#ifndef P0_MOVED
#define P0_MOVED 1536
#endif
__device__ __forceinline__ void convert_items(Frame& F, int it0, int it1, int gw, int nw) {
    int lane_ = F.lane, wave_ = F.wave; asm volatile("" : "+v"(lane_), "+s"(wave_));
    LAS float* scr = (LAS float*)(F.lds + wave_ * 16640);
    for (int it = it0 + gw; it < it1; it += nw) {
        int r = it;
        if (r < P0_I_OUT) { const int kb = r / 64, nb = r % 64, n0 = 64 * nb; transpose_item(F.w_out, DM, DM, 64 * kb, n0, 64, F.WOUT + (size_t)n0 * DM, scr, lane_); continue; } r -= P0_I_OUT;
        if (r < 2 * P0_I_G) { const int up = r >= P0_I_G; if (up) r -= P0_I_G; const int nbn = DFF / 64, kb = r / nbn, nb = r % nbn, n0 = 64 * nb;
            const int row0 = (n0 / 128) * 256 + up * 128 + (n0 % 128);
            transpose_item(up ? F.w_ffn_up : F.w_ffn_gate, DFF, DM, 64 * kb, n0, 64, F.WGU + (size_t)row0 * DM, scr, lane_); continue; } r -= 2 * P0_I_G;
        if (r < P0_I_D) { const int kb = r / 64, nb = r % 64, n0 = 64 * nb; transpose_item(F.w_ffn_down, DM, DFF, 64 * kb, n0, 64, F.WDN + (size_t)n0 * DFF, scr, lane_); continue; } r -= P0_I_D;
        { const int kb = r / P0_NB_IN, nb = r % P0_NB_IN, n0 = 64 * nb; transpose_item(F.w_in, INC, DM, 64 * kb, n0, INC - n0 >= 64 ? 64 : INC - n0, F.WIN + (size_t)n0 * DM, scr, lane_); }
    }
}
struct CvtItem { const float* src; bf16* dst; int ldw, K, k0; };
__device__ __forceinline__ CvtItem cvt_decode(const Frame& F, int it) {
    int r = it - P0_I_OUT; CvtItem c;
    if (r < 2 * P0_I_G) { const int up = r >= P0_I_G; if (up) r -= P0_I_G; const int nbn = DFF / 64, kb = r / nbn, nb = r % nbn, n0 = 64 * nb, row0 = (n0 / 128) * 256 + up * 128 + (n0 % 128);
        c.src = (up ? F.w_ffn_up : F.w_ffn_gate) + (size_t)(64 * kb) * DFF + n0; c.dst = F.WGU + (size_t)row0 * DM; c.ldw = DFF; c.K = DM; c.k0 = 64 * kb; return c; }
    r -= 2 * P0_I_G; { const int kb = r / 64, nb = r % 64, n0 = 64 * nb; c.src = F.w_ffn_down + (size_t)(64 * kb) * DM + n0; c.dst = F.WDN + (size_t)n0 * DFF; c.ldw = DM; c.K = DFF; c.k0 = 64 * kb; return c; }
}
__device__ __forceinline__ void cvt_load(const CvtItem& c, int lane, float (&v)[64]) {
    const float* s = c.src + lane;
#pragma unroll
    for (int kk = 0; kk < 64; ++kk) v[kk] = s[(size_t)kk * c.ldw];
}
__device__ __forceinline__ void cvt_store(const CvtItem& c, int lane, const float (&v)[64], LAS float* scr) {
#pragma unroll
    for (int kk = 0; kk < 64; ++kk) scr[kk * 65 + lane] = v[kk];
    LDS_WAIT(); asm volatile("" ::: "memory");
    const int c8 = lane & 7;
#pragma unroll
    for (int j = 0; j < 8; ++j) { const int n = (lane >> 3) + 8 * j; const LAS float* s = scr + (8 * c8) * 65 + n;
        v4u o; o.x = pk2hw(s[0 * 65], s[1 * 65]); o.y = pk2hw(s[2 * 65], s[3 * 65]); o.z = pk2hw(s[4 * 65], s[5 * 65]); o.w = pk2hw(s[6 * 65], s[7 * 65]);
        *(GAS v4u*)(c.dst + (size_t)n * c.K + c.k0 + 8 * c8) = o; }
    LDS_WAIT(); asm volatile("" ::: "memory");
}
__device__ __forceinline__ void convert_items_pipelined(Frame& F, int it0, int it1, int gw, int nw) {
    int lane_ = F.lane, wave_ = F.wave; asm volatile("" : "+v"(lane_), "+s"(wave_));
    LAS float* scr = (LAS float*)(F.lds + wave_ * 16640);
    int it = it0 + gw; if (it >= it1) return;
    float va[64], vb[64]; CvtItem ca = cvt_decode(F, it), cb = ca; cvt_load(ca, lane_, va);
    for (;;) {
        const int i1 = it + nw; const bool h1 = i1 < it1; if (h1) { cb = cvt_decode(F, i1); cvt_load(cb, lane_, vb); }
        cvt_store(ca, lane_, va, scr);
        if (!h1) break;
        const int i2 = i1 + nw; const bool h2 = i2 < it1; if (h2) { ca = cvt_decode(F, i2); cvt_load(ca, lane_, va); }
        cvt_store(cb, lane_, vb, scr);
        if (!h2) break;
        it = i2;
    }
}
#ifndef P1_DED
#define P1_DED 12288
#endif
__device__ __forceinline__ void p0_prologue(Frame& F) {
    const int gw = F.wg * NWAVES + F.wave, NGW = F.G * NWAVES;
    constexpr int FFN_END = P0_I_OUT + 2 * P0_I_G + P0_I_D;
#pragma unroll
    for (int rp = 0; rp < 1; ++rp) { convert_items(F, 0, FFN_END - P0_MOVED - (F.G == 256 ? P1_DED : 0), gw, NGW); convert_items(F, FFN_END, P0_NITEMS, gw, NGW); }
#pragma unroll
    for (int rp = 0; rp < 1; ++rp) { RowGain RG; row_gain_load(F.g_mix, F.lane, RG); for (int m = gw; m < M; m += NGW) rms_row_to_bf16(x_row(F, m), RG, F.HN + (size_t)m * DM, F.lane); }
}

__device__ __forceinline__ void ln_mean_rstd(const Frame& F, int m, float& mean, float& rstd) {
    const float s1 = ((const float*)(F.ctl + CW_VST))[2 * m], s2 = ((const float*)(F.ctl + CW_VST))[2 * m + 1];
    mean = s1 * (1.f / AWID); rstd = 1.0f / sqrtf(fmaxf(s2 * (1.f / AWID) - mean * mean, 0.f) + EPS);
}
__device__ __forceinline__ void ln_sample_row(Frame& F, int m) {
    const GAS v4u* vr = (const GAS v4u*)(F.PROJ + (size_t)m * NPROJ + C_V) + F.lane;
    float mean, rstd; ln_mean_rstd(F, m, mean, rstd);
    float* o = F.out + O_SV + (size_t)(m - MP) * AWID;
#pragma unroll
    for (int i = 0; i < 4; ++i) { const v4u w = vr[64 * i]; const int c = 8 * (F.lane + 64 * i);
        const float f[8] = {bflo(w.x), bfhi(w.x), bflo(w.y), bfhi(w.y), bflo(w.z), bfhi(w.z), bflo(w.w), bfhi(w.w)};
        const f32x4 g0 = *(const f32x4*)(F.ln_g + c), g1 = *(const f32x4*)(F.ln_g + c + 4), b0 = *(const f32x4*)(F.ln_b + c), b1 = *(const f32x4*)(F.ln_b + c + 4);
        f32x4 o0, o1;
        o0.x = (f[0] - mean) * rstd * g0.x + b0.x; o0.y = (f[1] - mean) * rstd * g0.y + b0.y; o0.z = (f[2] - mean) * rstd * g0.z + b0.z; o0.w = (f[3] - mean) * rstd * g0.w + b0.w;
        o1.x = (f[4] - mean) * rstd * g1.x + b1.x; o1.y = (f[5] - mean) * rstd * g1.y + b1.y; o1.z = (f[6] - mean) * rstd * g1.z + b1.z; o1.w = (f[7] - mean) * rstd * g1.w + b1.w;
        *(f32x4*)(o + c) = o0; *(f32x4*)(o + c + 4) = o1; }
}
__device__ __forceinline__ float log_sigmoid_f(float z) { return fminf(z, 0.f) - __logf(1.0f + __expf(-fabsf(z))); }
constexpr int PREP_GLR = 0, PREP_TOT = 4096, PREP_BREF = 5120, PREP_BLAST = 6144, PREP_QD = 8192, PREP_PITCH = 264, PREP_KD = PREP_QD + 64 * PREP_PITCH * 2, PREP_END = PREP_KD + 64 * PREP_PITCH * 2;
static_assert(PREP_END <= RING_BYTES, "prep LDS");
__device__ __forceinline__ void gla_prep_unit(Frame& F, int bh) {
    const int blk = bh >> 2, h = bh & 3, m0 = 64 * blk, kd = F.tid & 255, half = F.tid >> 8;
    LAS float* glr_l = (LAS float*)(F.lds + PREP_GLR); LAS float* tot = (LAS float*)(F.lds + PREP_TOT); LAS float* bref = (LAS float*)(F.lds + PREP_BREF); LAS float* blast = (LAS float*)(F.lds + PREP_BLAST);
    LAS bf16* QD = (LAS bf16*)(F.lds + PREP_QD); LAS bf16* KD = (LAS bf16*)(F.lds + PREP_KD);
    v4u qraw[4], kraw[4];
#pragma unroll
    for (int r = 0; r < 4; ++r) { const int q = F.tid + 512 * r, row = q >> 5, c = q & 31; const bf16* src = F.PROJ + (size_t)(m0 + row) * NPROJ + C_Q + h * HK + 8 * c;
        qraw[r] = *(const GAS v4u*)src; kraw[r] = *(const GAS v4u*)(src + (C_K - C_Q)); }
    for (int i = F.tid; i < 64 * 16; i += NWAVES * 64) glr_l[i] = F.GLR[(size_t)m0 * 16 + i];
    float wg[16];
#pragma unroll
    for (int r = 0; r < 16; ++r) wg[r] = F.w_gate_up[r * 1024 + h * HK + kd];
    const float bg = F.b_gate[h * HK + kd];
#pragma unroll
    for (int r = 0; r < 4; ++r) { const int q = F.tid + 512 * r, row = q >> 5, c = q & 31; *(LAS v4u*)(QD + row * PREP_PITCH + 8 * c) = qraw[r]; *(LAS v4u*)(KD + row * PREP_PITCH + 8 * c) = kraw[r]; }
    LDS_BARRIER();
    float c[32]; float run = 0.f;
#pragma unroll
    for (int tt = 0; tt < 32; ++tt) { const int t = 32 * half + tt; float z = bg;
#pragma unroll
        for (int r4 = 0; r4 < 4; ++r4) { const f32x4 gv = *(const LAS f32x4*)(glr_l + t * 16 + 4 * r4); z += gv.x * wg[4 * r4] + gv.y * wg[4 * r4 + 1] + gv.z * wg[4 * r4 + 2] + gv.w * wg[4 * r4 + 3]; }
        run += log_sigmoid_f(z) * 0.0625f; c[tt] = run; }
    if (half == 0) tot[kd] = run;
    LDS_BARRIER();
    if (half == 1) { const float add = tot[kd];
#pragma unroll
        for (int tt = 0; tt < 32; ++tt) c[tt] += add;
        bref[kd] = c[0]; blast[kd] = c[31]; F.BLAST[(size_t)bh * HK + kd] = c[31]; }
    LDS_BARRIER();
    const float br = bref[kd], bl = blast[kd], ebr = __expf(br), ebl = __expf(bl - br);
    unsigned klp[16];
    bf16* qdst = F.QE + (size_t)(m0 + 32 * half) * 1024 + h * HK + kd;
#pragma unroll
    for (int tt = 0; tt < 32; tt += 2) { float klv[2];
#pragma unroll
        for (int e = 0; e < 2; ++e) { const int t = 32 * half + tt + e; const float e1 = __expf(c[tt + e] - br), r1 = __builtin_amdgcn_rcpf(e1);
            const float qv = bf2f(QD[t * PREP_PITCH + kd]), kv = bf2f(KD[t * PREP_PITCH + kd]);
            QD[t * PREP_PITCH + kd] = (bf16)f2bf(qv * e1); KD[t * PREP_PITCH + kd] = (bf16)f2bf(kv * r1);
            qdst[(size_t)(tt + e) * 1024] = (bf16)f2bf(qv * e1 * ebr);
            klv[e] = kv * r1 * ebl; }
        klp[tt >> 1] = pk2(klv[0], klv[1]); }
    { GAS v4u* kt = (GAS v4u*)(F.KLT + ((size_t)bh * HK + kd) * 64 + 32 * half);
#pragma unroll
      for (int i = 0; i < 4; ++i) { v4u w; w.x = klp[4 * i]; w.y = klp[4 * i + 1]; w.z = klp[4 * i + 2]; w.w = klp[4 * i + 3]; kt[i] = w; } }
    LDS_BARRIER();
    const int cl = F.lane & 15, g = F.lane >> 4;
#pragma unroll
    for (int rep = 0; rep < 2; ++rep) { const int tile = F.wave + 8 * rep, it = tile >> 2, jt = tile & 3; f32x4 acc = {0.f, 0.f, 0.f, 0.f};
        if (jt <= it) {
#pragma unroll
            for (int kk = 0; kk < 8; ++kk) { const bf16x8 a = *(const LAS bf16x8*)(KD + (16 * jt + cl) * PREP_PITCH + 32 * kk + 8 * g); const bf16x8 b = *(const LAS bf16x8*)(QD + (16 * it + cl) * PREP_PITCH + 32 * kk + 8 * g);
                acc = MFMA16(a, b, acc); } }
        const int i = 16 * it + cl, j0 = 16 * jt + 4 * g;
        v2u w; w.x = pk2(j0 <= i ? acc.x : 0.f, j0 + 1 <= i ? acc.y : 0.f); w.y = pk2(j0 + 2 <= i ? acc.z : 0.f, j0 + 3 <= i ? acc.w : 0.f);
        *(GAS v2u*)(F.ATT + (size_t)bh * 4096 + i * 64 + j0) = w; }
    LDS_BARRIER();
}
constexpr int VT_PITCH = 520;
static_assert(64 * VT_PITCH * 2 <= RING_BYTES, "vt LDS");
__device__ __forceinline__ void v_transpose_unit(Frame& F, int bh) {
    const int blk = bh >> 2, h = bh & 3, m0 = 64 * blk; LAS bf16* tile = (LAS bf16*)F.lds;
    { const int row = F.tid >> 3, piece = F.tid & 7; const GAS v4u* src = (const GAS v4u*)(F.PROJ + (size_t)(m0 + row) * NPROJ + C_VV + h * HV + piece * 64);
      LAS v4u* dst = (LAS v4u*)(tile + row * VT_PITCH + piece * 64);
#pragma unroll
      for (int i = 0; i < 8; ++i) dst[i] = src[i]; }
    LDS_BARRIER();
    { const int e = F.tid; unsigned p[32];
#pragma unroll
      for (int j = 0; j < 64; j += 2) p[j >> 1] = (unsigned)tile[j * VT_PITCH + e] | ((unsigned)tile[(j + 1) * VT_PITCH + e] << 16);
      GAS v4u* dst = (GAS v4u*)(F.VT + ((size_t)bh * HV + e) * 64);
#pragma unroll
      for (int i = 0; i < 8; ++i) { v4u w; w.x = p[4 * i]; w.y = p[4 * i + 1]; w.z = p[4 * i + 2]; w.w = p[4 * i + 3]; dst[i] = w; } }
    LDS_BARRIER();
}

constexpr int SGU_PITCH = 136;
struct SguPre { v4u vr[4]; v2u uw[8]; float s1, s2; };
__device__ __forceinline__ void sgu_prefetch(Frame& F, int un, SguPre& o) {
    const int ck = un >> 4, a = un & 15; const int m0 = ck < 128 ? 128 * ck : MP + 64 * (ck - 128), clen = ck < 128 ? 128 : 64;
    const int it = F.wave, cl = F.lane & 15, g = F.lane >> 4;
    const bool act = 16 * it < clen; const int i = act ? 16 * it + cl : 0;
    { const int j = F.tid >> 2, qd = F.tid & 3;
      if (j < clen) { const int m = m0 + j; const GAS v4u* src = (const GAS v4u*)(F.PROJ + (size_t)m * NPROJ + C_V + a * AHD + 32 * qd);
#pragma unroll
          for (int q = 0; q < 4; ++q) o.vr[q] = src[q];
          o.s1 = ((const float*)(F.ctl + CW_VST))[2 * m]; o.s2 = ((const float*)(F.ctl + CW_VST))[2 * m + 1]; } }
    { const bf16* urow = F.PROJ + (size_t)(m0 + i) * NPROJ + C_U + a * AHD + 4 * g;
#pragma unroll
      for (int dt = 0; dt < 8; ++dt) o.uw[dt] = *(const GAS v2u*)(urow + 16 * dt); }
}
struct SguW { v4u bw[4]; float bs; int a; float lg[32], lb[32]; };
__device__ __forceinline__ void sgu_unit(Frame& F, int un, SguPre& cur, int un_next, SguW& W) {
    const int ck = un >> 4, a = un & 15; const int m0 = ck < 128 ? 128 * ck : MP + 64 * (ck - 128), clen = ck < 128 ? 128 : 64;
    LAS bf16* VnT = (LAS bf16*)F.lds;
    const int it = F.wave, cl = F.lane & 15, g = F.lane >> 4;
    const bool act = 16 * it < clen; const int i = act ? 16 * it + cl : 0, nk = (it >> 1) + 1;
    if (W.a != a) {
        const int iw = 16 * it + cl;
#pragma unroll
        for (int kk = 0; kk < 4; ++kk) { const float* wrow = F.w_s + ((size_t)a * 128 + iw) * 128 + 32 * kk + 8 * g; const f32x4 w0 = *(const f32x4*)wrow, w1 = *(const f32x4*)(wrow + 4);
            const int j0 = 32 * kk + 8 * g;
            W.bw[kk].x = pk2(j0 <= iw ? w0.x : 0.f, j0 + 1 <= iw ? w0.y : 0.f); W.bw[kk].y = pk2(j0 + 2 <= iw ? w0.z : 0.f, j0 + 3 <= iw ? w0.w : 0.f);
            W.bw[kk].z = pk2(j0 + 4 <= iw ? w1.x : 0.f, j0 + 5 <= iw ? w1.y : 0.f); W.bw[kk].w = pk2(j0 + 6 <= iw ? w1.z : 0.f, j0 + 7 <= iw ? w1.w : 0.f); }
        W.bs = F.b_s[a * 128 + iw]; W.a = a;
        { const int qd = F.tid & 3; const f32x4* lg4 = (const f32x4*)(F.ln_g + a * AHD + 32 * qd); const f32x4* lb4 = (const f32x4*)(F.ln_b + a * AHD + 32 * qd);
#pragma unroll
          for (int q = 0; q < 8; ++q) { const f32x4 x = lg4[q], y = lb4[q]; W.lg[4 * q] = x.x; W.lg[4 * q + 1] = x.y; W.lg[4 * q + 2] = x.z; W.lg[4 * q + 3] = x.w; W.lb[4 * q] = y.x; W.lb[4 * q + 1] = y.y; W.lb[4 * q + 2] = y.z; W.lb[4 * q + 3] = y.w; } } }
    const float bs = W.bs;
    { const int j = F.tid >> 2, qd = F.tid & 3;
      if (j < clen) { const float mu = cur.s1 * (1.f / AWID), rs = 1.0f / sqrtf(fmaxf(cur.s2 * (1.f / AWID) - mu * mu, 0.f) + EPS);
#pragma unroll
          for (int q = 0; q < 4; ++q) { const v4u w = cur.vr[q]; const float f[8] = {bflo(w.x), bfhi(w.x), bflo(w.y), bfhi(w.y), bflo(w.z), bfhi(w.z), bflo(w.w), bfhi(w.w)};
#pragma unroll
              for (int k = 0; k < 8; ++k) { const int d = 8 * q + k; VnT[(32 * qd + d) * SGU_PITCH + j] = (bf16)f2bf((f[k] - mu) * rs * W.lg[d] + W.lb[d]); } } } }
    v2u uw[8];
#pragma unroll
    for (int dt = 0; dt < 8; ++dt) uw[dt] = cur.uw[dt];
    LDS_BARRIER();
    if (un_next >= 0) sgu_prefetch(F, un_next, cur);
    if (act) {
        f32x4 acc[8];
#pragma unroll
        for (int dt = 0; dt < 8; ++dt) acc[dt] = (f32x4){0.f, 0.f, 0.f, 0.f};
#pragma unroll
        for (int kk = 0; kk < 4; ++kk) if (kk < nk) {
            const bf16x8 bfrag = __builtin_bit_cast(bf16x8, W.bw[kk]);
#pragma unroll
            for (int dt = 0; dt < 8; ++dt) { const bf16x8 afrag = *(const LAS bf16x8*)(VnT + (16 * dt + cl) * SGU_PITCH + 32 * kk + 8 * g); acc[dt] = MFMA16(afrag, bfrag, acc[dt]); } }
        bf16* orow = F.MIX + (size_t)(m0 + i) * DM + a * AHD + 4 * g;
#pragma unroll
        for (int dt = 0; dt < 8; ++dt) {
            v2u w; w.x = pk2(bflo(uw[dt].x) * (acc[dt].x + bs), bfhi(uw[dt].x) * (acc[dt].y + bs)); w.y = pk2(bflo(uw[dt].y) * (acc[dt].z + bs), bfhi(uw[dt].y) * (acc[dt].w + bs));
            *(GAS v2u*)(orow + 16 * dt) = w; }
    }
    LDS_BARRIER();
}

struct ChainRegs { f32x4 S[2][4]; };
struct ChainOpsU { bf16x8 ka[2][2]; bf16x8 vb[4][2]; f32x4 bl[2]; };
struct ChainOpsO { bf16x8 qb[8]; bf16x8 ab[2]; };
__device__ __forceinline__ void chain_load_u(const Frame& F, int bh, int wv, int g, int cl, int es, ChainOpsU& P) {
#pragma unroll
    for (int dt = 0; dt < 2; ++dt)
#pragma unroll
        for (int kk = 0; kk < 2; ++kk) P.ka[dt][kk] = *(const GAS bf16x8*)(F.KLT + ((size_t)bh * HK + 32 * wv + 16 * dt + cl) * 64 + 32 * kk + 8 * g);
#pragma unroll
    for (int et = 0; et < 4; ++et)
#pragma unroll
        for (int kk = 0; kk < 2; ++kk) P.vb[et][kk] = *(const GAS bf16x8*)(F.VT + ((size_t)bh * HV + 64 * es + 16 * et + cl) * 64 + 32 * kk + 8 * g);
#pragma unroll
    for (int dt = 0; dt < 2; ++dt) P.bl[dt] = *(const GAS f32x4*)(F.BLAST + (size_t)bh * HK + 32 * wv + 16 * dt + 4 * g);
}
__device__ __forceinline__ void chain_load_o(const Frame& F, int blk, int h, int it, int g, int cl, ChainOpsO& P) {
    const bf16* qrow = F.QE + (size_t)(64 * blk + 16 * it + cl) * 1024 + h * HK + 8 * g;
#pragma unroll
    for (int kk = 0; kk < 8; ++kk) P.qb[kk] = *(const GAS bf16x8*)(qrow + 32 * kk);
#pragma unroll
    for (int kk = 0; kk < 2; ++kk) P.ab[kk] = *(const GAS bf16x8*)(F.ATT + (size_t)(blk * 4 + h) * 4096 + (16 * it + cl) * 64 + 32 * kk + 8 * g);
}
__device__ __forceinline__ void chain_update(ChainRegs& R, const ChainOpsU& P) {
#pragma unroll
    for (int dt = 0; dt < 2; ++dt) { f32x4 dec; dec.x = __expf(P.bl[dt].x); dec.y = __expf(P.bl[dt].y); dec.z = __expf(P.bl[dt].z); dec.w = __expf(P.bl[dt].w);
#pragma unroll
        for (int et = 0; et < 4; ++et) { f32x4 s = R.S[dt][et] * dec;
#pragma unroll
            for (int kk = 0; kk < 2; ++kk) s = MFMA16(P.ka[dt][kk], P.vb[et][kk], s);
            R.S[dt][et] = s; } }
}
__device__ __forceinline__ void chain_load(const float* base, int wv, int g, int cl, int es, ChainRegs& R) {
#pragma unroll
    for (int dt = 0; dt < 2; ++dt)
#pragma unroll
        for (int et = 0; et < 4; ++et) { const float* p = base + (size_t)(32 * wv + 16 * dt + 4 * g) * HV + 64 * es + 16 * et + cl;
            R.S[dt][et] = (f32x4){p[0], p[HV], p[2 * HV], p[3 * HV]}; }
}
__device__ __forceinline__ void chain_store(float* base, int wv, int g, int cl, int es, const ChainRegs& R) {
#pragma unroll
    for (int dt = 0; dt < 2; ++dt)
#pragma unroll
        for (int et = 0; et < 4; ++et) { float* p = base + (size_t)(32 * wv + 16 * dt + 4 * g) * HV + 64 * es + 16 * et + cl;
            p[0] = R.S[dt][et].x; p[HV] = R.S[dt][et].y; p[2 * HV] = R.S[dt][et].z; p[3 * HV] = R.S[dt][et].w; }
}
__device__ __forceinline__ void lst_store(float* base, int wv, int es, int lane, const ChainRegs& R) {
    GAS f32x4* p = (GAS f32x4*)base + ((size_t)(es * 8 + wv) * 8) * 64 + lane;
#pragma unroll
    for (int dt = 0; dt < 2; ++dt)
#pragma unroll
        for (int et = 0; et < 4; ++et) p[(dt * 4 + et) * 64] = R.S[dt][et];
}
__device__ __forceinline__ void lst_load(const float* base, int wv, int es, int lane, ChainRegs& R) {
    const GAS f32x4* p = (const GAS f32x4*)base + ((size_t)(es * 8 + wv) * 8) * 64 + lane;
#pragma unroll
    for (int dt = 0; dt < 2; ++dt)
#pragma unroll
        for (int et = 0; et < 4; ++et) R.S[dt][et] = p[(dt * 4 + et) * 64];
}
__device__ __forceinline__ void chain_decode(int un, int& gs, int& h, int& es) { const int x = un & 7, idx = (un >> 3) & 31, hi = un >> 8; const int gh = x * 4 + (idx >> 3); es = idx & 7; h = gh & 3; gs = hi * 8 + (gh >> 2); }
struct ChainOpsK1 { bf16x8 ka[2][2]; f32x4 bl[2]; };
__device__ __forceinline__ void chain_load_k1(const Frame& F, int bh, int wv, int g, int cl, ChainOpsK1& P) {
#pragma unroll
    for (int dt = 0; dt < 2; ++dt)
#pragma unroll
        for (int kk = 0; kk < 2; ++kk) P.ka[dt][kk] = *(const GAS bf16x8*)(F.KLT + ((size_t)bh * HK + 32 * wv + 16 * dt + cl) * 64 + 32 * kk + 8 * g);
#pragma unroll
    for (int dt = 0; dt < 2; ++dt) P.bl[dt] = *(const GAS f32x4*)(F.BLAST + (size_t)bh * HK + 32 * wv + 16 * dt + 4 * g);
}
constexpr int P1V_PITCH = 72;
__device__ __forceinline__ void chain_step_kv(ChainRegs& R, const ChainOpsK1& P, const LAS bf16* vimg, int g, int cl) {
    bf16x8 vb[4][2];
#pragma unroll
    for (int et = 0; et < 4; ++et)
#pragma unroll
        for (int kk = 0; kk < 2; ++kk) vb[et][kk] = *(const LAS bf16x8*)(vimg + (16 * et + cl) * P1V_PITCH + 32 * kk + 8 * g);
#pragma unroll
    for (int dt = 0; dt < 2; ++dt) { f32x4 dec; dec.x = __expf(P.bl[dt].x); dec.y = __expf(P.bl[dt].y); dec.z = __expf(P.bl[dt].z); dec.w = __expf(P.bl[dt].w);
#pragma unroll
        for (int et = 0; et < 4; ++et) { f32x4 s = R.S[dt][et] * dec;
#pragma unroll
            for (int kk = 0; kk < 2; ++kk) s = MFMA16(P.ka[dt][kk], vb[et][kk], s);
            R.S[dt][et] = s; } }
}
__device__ __forceinline__ void chain_pass1_unit(Frame& F, int un) {
    int gp, h, es; chain_decode(un, gp, h, es); const int wv = F.wave, g = F.lane >> 4, cl = F.lane & 15;
    if (gp >= NG - 1) return;
    ChainRegs R;
#pragma unroll
    for (int dt = 0; dt < 2; ++dt)
#pragma unroll
        for (int et = 0; et < 4; ++et) R.S[dt][et] = (f32x4){0.f, 0.f, 0.f, 0.f};
    f32x4 bsum[2] = {{0.f, 0.f, 0.f, 0.f}, {0.f, 0.f, 0.f, 0.f}};
    LAS bf16* VB = (LAS bf16*)F.lds;
    const int prow = 8 * wv + (F.lane >> 3), pcol = 8 * (F.lane & 7), poff = prow * P1V_PITCH + pcol;
    const bf16* pbase = F.VT + ((size_t)64 * es + prow) * 64 + pcol;
    ChainOpsK1 PA, PB; const int bh0 = (GB * gp) * 4 + h;
    bf16x8 pc0 = *(const GAS bf16x8*)(pbase + (size_t)bh0 * HV * 64), pc1 = *(const GAS bf16x8*)(pbase + (size_t)(bh0 + 4) * HV * 64);
    chain_load_k1(F, bh0, wv, g, cl, PA);
    *(LAS bf16x8*)(VB + poff) = pc0;
    LDS_BARRIER();
    for (int s = 0; s < GB; s += 2) {
        chain_load_k1(F, bh0 + 4 * (s + 1), wv, g, cl, PB);
        pc0 = *(const GAS bf16x8*)(pbase + (size_t)(bh0 + 4 * (s + 2 < GB ? s + 2 : s)) * HV * 64);
        *(LAS bf16x8*)(VB + 64 * P1V_PITCH + poff) = pc1;
        chain_step_kv(R, PA, VB, g, cl); bsum[0] += PA.bl[0]; bsum[1] += PA.bl[1];
        LDS_BARRIER();
        chain_load_k1(F, bh0 + 4 * (s + 2 < GB ? s + 2 : s), wv, g, cl, PA);
        pc1 = *(const GAS bf16x8*)(pbase + (size_t)(bh0 + 4 * (s + 3 < GB ? s + 3 : s)) * HV * 64);
        *(LAS bf16x8*)(VB + poff) = pc0;
        chain_step_kv(R, PB, VB + 64 * P1V_PITCH, g, cl); bsum[0] += PB.bl[0]; bsum[1] += PB.bl[1];
        LDS_BARRIER();
    }
    lst_store(F.LST + (size_t)(gp * 4 + h) * HK * HV, wv, es, F.lane, R);
    if (es == 0 && cl == 0) { *(GAS f32x4*)(F.GDEC + (size_t)(gp * 4 + h) * HK + 32 * wv + 4 * g) = bsum[0]; *(GAS f32x4*)(F.GDEC + (size_t)(gp * 4 + h) * HK + 32 * wv + 16 + 4 * g) = bsum[1]; }
}
constexpr int SL_PITCH = 264, SL_BYTES = 64 * SL_PITCH * 2, AL_PITCH = 72, AL_BYTES = 64 * AL_PITCH * 2;
constexpr int CH_SL = 0, CH_QL = SL_BYTES, CH_AL = 2 * SL_BYTES, CH_VL = CH_AL + AL_BYTES, CH_END = CH_VL + AL_BYTES;
static_assert(CH_END <= RING_BYTES, "chain LDS");
struct ChainStage { v4u q[4]; v4u a; v4u v; };
struct ChainOpsK { bf16x8 ka[2][2]; f32x4 bl[2]; };
__device__ __forceinline__ void chain_stage_load(const Frame& F, int blk, int h, int es, ChainStage& T) {
    const int bh = blk * 4 + h;
#pragma unroll
    for (int k = 0; k < 4; ++k) { const int q = F.tid + 512 * k, row = q >> 5, c = q & 31; T.q[k] = *(const GAS v4u*)(F.QE + (size_t)(64 * blk + row) * 1024 + h * HK + 8 * c); }
    const int row = F.tid >> 3, c = F.tid & 7;
    T.a = *(const GAS v4u*)(F.ATT + (size_t)bh * 4096 + row * 64 + 8 * c);
    T.v = *(const GAS v4u*)(F.VT + ((size_t)bh * HV + 64 * es + row) * 64 + 8 * c);
}
__device__ __forceinline__ void chain_stage_write(const Frame& F, const ChainStage& T) {
#pragma unroll
    for (int k = 0; k < 4; ++k) { const int q = F.tid + 512 * k, row = q >> 5, c = q & 31; *(LAS v4u*)(F.lds + CH_QL + (row * SL_PITCH + 8 * c) * 2) = T.q[k]; }
    const int row = F.tid >> 3, c = F.tid & 7;
    *(LAS v4u*)(F.lds + CH_AL + (row * AL_PITCH + 8 * c) * 2) = T.a;
    *(LAS v4u*)(F.lds + CH_VL + (row * AL_PITCH + 8 * c) * 2) = T.v;
}
__device__ __forceinline__ void chain_load_k(const Frame& F, int bh, int wv, int g, int cl, ChainOpsK& P) {
#pragma unroll
    for (int dt = 0; dt < 2; ++dt)
#pragma unroll
        for (int kk = 0; kk < 2; ++kk) P.ka[dt][kk] = *(const GAS bf16x8*)(F.KLT + ((size_t)bh * HK + 32 * wv + 16 * dt + cl) * 64 + 32 * kk + 8 * g);
#pragma unroll
    for (int dt = 0; dt < 2; ++dt) P.bl[dt] = *(const GAS f32x4*)(F.BLAST + (size_t)bh * HK + 32 * wv + 16 * dt + 4 * g);
}
__device__ __forceinline__ void chain_write_sl(LAS unsigned char* sl, int wv, int g, int cl, const ChainRegs& R) {
#pragma unroll
    for (int dt = 0; dt < 2; ++dt)
#pragma unroll
        for (int et = 0; et < 4; ++et) { v2u w; w.x = pk2(R.S[dt][et].x, R.S[dt][et].y); w.y = pk2(R.S[dt][et].z, R.S[dt][et].w);
            *(LAS v2u*)(sl + ((16 * et + cl) * SL_PITCH + 32 * wv + 16 * dt + 4 * g) * 2) = w; }
}
__device__ __forceinline__ void chain_step_compute(Frame& F, int blk, int h, int es, ChainRegs& R, const ChainOpsK& PK) {
    const int wv = F.wave, g = F.lane >> 4, cl = F.lane & 15, it = wv >> 1, eh = wv & 1;
    const LAS unsigned char* sl = F.lds + CH_SL; const LAS unsigned char* ql = F.lds + CH_QL; const LAS unsigned char* al = F.lds + CH_AL; const LAS unsigned char* vl = F.lds + CH_VL;
    f32x4 o0 = {0.f, 0.f, 0.f, 0.f}, o1 = {0.f, 0.f, 0.f, 0.f};
#pragma unroll 1
    for (int k2 = 0; k2 < 8; k2 += 2) {
#pragma unroll
        for (int kq = 0; kq < 2; ++kq) { const int kk = k2 + kq; const bf16x8 qb = *(const LAS bf16x8*)(ql + ((16 * it + cl) * SL_PITCH + 32 * kk + 8 * g) * 2);
            const bf16x8 s0 = *(const LAS bf16x8*)(sl + ((16 * (2 * eh) + cl) * SL_PITCH + 32 * kk + 8 * g) * 2), s1 = *(const LAS bf16x8*)(sl + ((16 * (2 * eh + 1) + cl) * SL_PITCH + 32 * kk + 8 * g) * 2);
            o0 = MFMA16(s0, qb, o0); o1 = MFMA16(s1, qb, o1); } }
#pragma unroll
    for (int kk = 0; kk < 2; ++kk) { const bf16x8 ab = *(const LAS bf16x8*)(al + ((16 * it + cl) * AL_PITCH + 32 * kk + 8 * g) * 2);
        const bf16x8 v0 = *(const LAS bf16x8*)(vl + ((16 * (2 * eh) + cl) * AL_PITCH + 32 * kk + 8 * g) * 2), v1 = *(const LAS bf16x8*)(vl + ((16 * (2 * eh + 1) + cl) * AL_PITCH + 32 * kk + 8 * g) * 2);
        o0 = MFMA16(v0, ab, o0); o1 = MFMA16(v1, ab, o1); }
    { bf16* orow = F.O + (size_t)(64 * blk + 16 * it + cl) * 2048 + h * HV + 64 * es + 32 * eh + 4 * g;
      v2u w; w.x = pk2(o0.x, o0.y); w.y = pk2(o0.z, o0.w); *(GAS v2u*)orow = w; w.x = pk2(o1.x, o1.y); w.y = pk2(o1.z, o1.w); *(GAS v2u*)(orow + 16) = w; }
    f32x4 dec[2];
#pragma unroll
    for (int dt = 0; dt < 2; ++dt) { dec[dt].x = __expf(PK.bl[dt].x); dec[dt].y = __expf(PK.bl[dt].y); dec[dt].z = __expf(PK.bl[dt].z); dec[dt].w = __expf(PK.bl[dt].w); }
#pragma unroll
    for (int et = 0; et < 4; ++et) {
        const bf16x8 vb0 = *(const LAS bf16x8*)(vl + ((16 * et + cl) * AL_PITCH + 8 * g) * 2), vb1 = *(const LAS bf16x8*)(vl + ((16 * et + cl) * AL_PITCH + 32 + 8 * g) * 2);
#pragma unroll
        for (int dt = 0; dt < 2; ++dt) { f32x4 s = R.S[dt][et] * dec[dt]; s = MFMA16(PK.ka[dt][0], vb0, s); s = MFMA16(PK.ka[dt][1], vb1, s); R.S[dt][et] = s; }
        __builtin_amdgcn_sched_barrier(0); }
}
__device__ __forceinline__ void chain_steps_o(Frame& F, int blk0, int nsteps, int h, int es, ChainRegs& R) {
    const int wv = F.wave, g = F.lane >> 4, cl = F.lane & 15, last = blk0 + nsteps - 1;
    ChainStage TA, TB; ChainOpsK K;
    chain_stage_load(F, blk0, h, es, TA); chain_load_k(F, blk0 * 4 + h, wv, g, cl, K);
    { const int b1 = blk0 + 1 <= last ? blk0 + 1 : last; chain_stage_load(F, b1, h, es, TB); }
    chain_write_sl(F.lds + CH_SL, wv, g, cl, R); chain_stage_write(F, TA);
    LDS_BARRIER();
    if (nsteps == 1) { chain_step_compute(F, blk0, h, es, R, K); LDS_BARRIER(); return; }
    for (int s = 0; s < nsteps; s += 2) {
        { const int b1 = blk0 + s + 1, b2 = blk0 + s + 2 <= last ? blk0 + s + 2 : last; chain_stage_load(F, b2, h, es, TA);
          chain_step_compute(F, blk0 + s, h, es, R, K);
          chain_load_k(F, b1 * 4 + h, wv, g, cl, K); }
        LDS_BARRIER();
        chain_write_sl(F.lds + CH_SL, wv, g, cl, R); chain_stage_write(F, TB);
        LDS_BARRIER();
        { const int b2 = blk0 + s + 2 <= last ? blk0 + s + 2 : last, b3 = blk0 + s + 3 <= last ? blk0 + s + 3 : last; chain_stage_load(F, b3, h, es, TB);
          chain_step_compute(F, blk0 + s + 1, h, es, R, K);
          chain_load_k(F, b2 * 4 + h, wv, g, cl, K); }
        LDS_BARRIER();
        chain_write_sl(F.lds + CH_SL, wv, g, cl, R); chain_stage_write(F, TA);
        LDS_BARRIER();
    }
}
__device__ __forceinline__ void chain_pass2_prompt_unit(Frame& F, int un) {
    int gp, h, es; chain_decode(un, gp, h, es); const int wv = F.wave, g = F.lane >> 4, cl = F.lane & 15;
    ChainRegs R;
#pragma unroll
    for (int dt = 0; dt < 2; ++dt)
#pragma unroll
        for (int et = 0; et < 4; ++et) R.S[dt][et] = (f32x4){0.f, 0.f, 0.f, 0.f};
    ChainRegs LA; f32x4 ga[2];
    if (gp > 0) { lst_load(F.LST + (size_t)h * HK * HV, wv, es, F.lane, LA);
#pragma unroll
        for (int dt = 0; dt < 2; ++dt) ga[dt] = *(const GAS f32x4*)(F.GDEC + (size_t)h * HK + 32 * wv + 16 * dt + 4 * g); }
    for (int q = 0; q < gp; ++q) {
        ChainRegs LB; f32x4 gb[2]; const int qn = q + 1 < gp ? q + 1 : q;
        lst_load(F.LST + (size_t)(qn * 4 + h) * HK * HV, wv, es, F.lane, LB);
#pragma unroll
        for (int dt = 0; dt < 2; ++dt) gb[dt] = *(const GAS f32x4*)(F.GDEC + (size_t)(qn * 4 + h) * HK + 32 * wv + 16 * dt + 4 * g);
#pragma unroll
        for (int dt = 0; dt < 2; ++dt) { const f32x4 gd = ga[dt];
            f32x4 dec; dec.x = __expf(gd.x); dec.y = __expf(gd.y); dec.z = __expf(gd.z); dec.w = __expf(gd.w);
#pragma unroll
            for (int et = 0; et < 4; ++et) R.S[dt][et] = R.S[dt][et] * dec + LA.S[dt][et]; }
#pragma unroll
        for (int dt = 0; dt < 2; ++dt) { ga[dt] = gb[dt];
#pragma unroll
            for (int et = 0; et < 4; ++et) LA.S[dt][et] = LB.S[dt][et]; } }
    chain_steps_o(F, GB * gp, GB, h, es, R);
    if (gp == NG - 1) chain_store(F.out + O_GP + (size_t)h * HK * HV, wv, g, cl, es, R);
}
__device__ __forceinline__ void chain_sample_unit(Frame& F, int un) {
    int st, h, es; chain_decode(un, st, h, es); const int wv = F.wave, g = F.lane >> 4, cl = F.lane & 15;
    ChainRegs R; chain_load(F.state_gla + (size_t)(st * 4 + h) * HK * HV, wv, g, cl, es, R);
    chain_steps_o(F, MP / 64 + st, 1, h, es, R);
    chain_store(F.out + O_GS + (size_t)(st * 4 + h) * HK * HV, wv, g, cl, es, R);
}

__device__ __forceinline__ void gla_finish_load(const Frame& F, int m, v4u (&w)[4], v4u (&rw)[4]) {
    const GAS v4u* orow = (const GAS v4u*)(F.O + (size_t)m * 2048) + F.lane; const GAS v4u* rrow = (const GAS v4u*)(F.PROJ + (size_t)m * NPROJ + C_R) + F.lane;
#pragma unroll
    for (int hh = 0; hh < 4; ++hh) { w[hh] = orow[64 * hh]; rw[hh] = rrow[64 * hh]; }
}
__device__ __forceinline__ void gla_finish_rows(Frame& F, int gw, int NGW) {
    const f32x4 g0 = *(const f32x4*)(F.gla_norm_g + 8 * F.lane), g1 = *(const f32x4*)(F.gla_norm_g + 8 * F.lane + 4);
    v4u wA[4], rA[4];
    if (gw < M) gla_finish_load(F, gw, wA, rA);
    for (int m = gw; m < M; m += NGW) {
        v4u wB[4], rB[4]; const int mn = m + NGW < M ? m + NGW : m;
        gla_finish_load(F, mn, wB, rB);
        GAS v4u* drow = (GAS v4u*)(F.MIX + (size_t)m * DM + 2048) + F.lane;
#pragma unroll
        for (int hh = 0; hh < 4; ++hh) { const v4u w = wA[hh], rw = rA[hh];
            const float f[8] = {bflo(w.x), bfhi(w.x), bflo(w.y), bfhi(w.y), bflo(w.z), bfhi(w.z), bflo(w.w), bfhi(w.w)};
            const float r[8] = {bflo(rw.x), bfhi(rw.x), bflo(rw.y), bfhi(rw.y), bflo(rw.z), bfhi(rw.z), bflo(rw.w), bfhi(rw.w)};
            float s = 0.f;
#pragma unroll
            for (int k = 0; k < 8; ++k) s += f[k] * f[k];
            const float rstd = 1.0f / sqrtf(wave_sum(s) * (1.f / HV) + EPS);
            v4u ow; ow.x = pk2hw(f[0] * rstd * g0.x * r[0], f[1] * rstd * g0.y * r[1]); ow.y = pk2hw(f[2] * rstd * g0.z * r[2], f[3] * rstd * g0.w * r[3]);
            ow.z = pk2hw(f[4] * rstd * g1.x * r[4], f[5] * rstd * g1.y * r[5]); ow.w = pk2hw(f[6] * rstd * g1.z * r[6], f[7] * rstd * g1.w * r[7]);
            drow[64 * hh] = ow; }
#pragma unroll
        for (int hh = 0; hh < 4; ++hh) { wA[hh] = wB[hh]; rA[hh] = rB[hh]; }
    }
}
__device__ __forceinline__ void final_norm_rows(Frame& F, int gw, int NGW) {
    const GAS f32x4* gr = (const GAS f32x4*)F.g_final; f32x4 g0[8], g1[8];
#pragma unroll
    for (int j = 0; j < 8; ++j) { const int c4 = 2 * (F.lane + 64 * j); g0[j] = gr[c4]; g1[j] = gr[c4 + 1]; }
    for (int m = gw; m < M; m += NGW) {
        const GAS v4u* xr = (const GAS v4u*)(F.HN + (size_t)m * DM) + F.lane; GAS f32x4* yr = (GAS f32x4*)(F.out + (size_t)m * DM);
        const float rstd = 1.0f / sqrtf(((const float*)(F.ctl + CW_SSQ2))[m] * (1.f / DM) + EPS);
        v4u w[8];
#pragma unroll
        for (int j = 0; j < 8; ++j) w[j] = xr[64 * j];
#pragma unroll
        for (int j = 0; j < 8; ++j) { const int c4 = 2 * (F.lane + 64 * j);
            f32x4 y0, y1; y0.x = bflo(w[j].x) * rstd * g0[j].x; y0.y = bfhi(w[j].x) * rstd * g0[j].y; y0.z = bflo(w[j].y) * rstd * g0[j].z; y0.w = bfhi(w[j].y) * rstd * g0[j].w;
            y1.x = bflo(w[j].z) * rstd * g1[j].x; y1.y = bfhi(w[j].z) * rstd * g1[j].y; y1.z = bflo(w[j].w) * rstd * g1[j].z; y1.w = bfhi(w[j].w) * rstd * g1[j].w;
            yr[c4] = y0; yr[c4 + 1] = y1; }
    }
}

#ifndef P9_WGM
#define P9_WGM 4
#endif
#ifndef GWGM
#define GWGM 9
#endif
#ifndef GWGM_P1
#define GWGM_P1 GWGM
#endif
#ifndef ALIGN_P6
#define ALIGN_P6 true
#endif
#ifndef GEMM_SP2
#define GEMM_SP2 true
#endif
#ifndef ALIGN_P1
#define ALIGN_P1 true
#endif
#ifndef ALIGN_P8
#define ALIGN_P8 true
#endif
#define PHASE_BEGIN(k) _Pragma("unroll") for (int _rep = 0; _rep < 1; ++_rep) {
#define PHASE_END(k) xcd_barrier(bar); }
struct Args { const float* in[18]; float* out; unsigned char* ws; };
__global__ void __launch_bounds__(NWAVES * 64, 2) fwd_kernel(Args args) {
    extern __shared__ __attribute__((aligned(16))) unsigned char lds[];
    Frame F;
    F.lds = (LAS unsigned char*)lds;
    F.tid = threadIdx.x; F.lane = F.tid & 63; F.wave = __builtin_amdgcn_readfirstlane(F.tid >> 6); F.G = gridDim.x; F.wg = blockIdx.x;
    unsigned char* ws = args.ws;
    F.ctl = (unsigned*)(ws + WS_CTL);
    F.x_prompt = args.in[0]; F.x_sample = args.in[1]; F.state_gla = args.in[2]; F.g_mix = args.in[3]; F.w_in = args.in[4]; F.w_s = args.in[5]; F.b_s = args.in[6]; F.ln_g = args.in[7]; F.ln_b = args.in[8];
    F.w_gate_up = args.in[9]; F.b_gate = args.in[10]; F.gla_norm_g = args.in[11]; F.w_out = args.in[12]; F.g_ffn = args.in[13]; F.w_ffn_gate = args.in[14]; F.w_ffn_up = args.in[15]; F.w_ffn_down = args.in[16]; F.g_final = args.in[17];
    F.out = args.out;
    F.WIN = (bf16*)(ws + WS_WIN); F.WOUT = (bf16*)(ws + WS_WOUT); F.WGU = (bf16*)(ws + WS_WGU); F.WDN = (bf16*)(ws + WS_WDN); F.HN = (bf16*)(ws + WS_HN); F.PROJ = (bf16*)(ws + WS_PROJ);
    F.MIX = (bf16*)(ws + WS_MIX); F.QE = (bf16*)(ws + WS_QE); F.KLT = (bf16*)(ws + WS_KLT); F.ATT = (bf16*)(ws + WS_ATT); F.VT = (bf16*)(ws + WS_VT); F.O = (bf16*)(ws + WS_O); F.HFF = (bf16*)(ws + WS_HFF);
    F.GLR = (float*)(ws + WS_GLR); F.STATS = (float*)(ws + WS_STATS); F.BLAST = (float*)(ws + WS_BLAST); F.LST = (float*)(ws + WS_LST); F.GDEC = (float*)(ws + WS_GDEC);
    for (int u = F.tid; u < (LDS_BYTES - PHASE_LDS) / 4; u += NWAVES * 64) ((LAS unsigned*)(F.lds + PHASE_LDS))[u] = 0u;
    __syncthreads();
    XcdBarrier bar = xcd_barrier_post(F.ctl + CW_BAR, (volatile LAS unsigned*)(F.lds + MISC_OFF + 32));
    const int gw = F.wg * NWAVES + F.wave, NGW = F.G * NWAVES;
    if (F.tid == 0) ((volatile LAS unsigned*)(F.lds + MISC_OFF))[0] = __hip_atomic_fetch_add(F.ctl + CW_XRANK + 16 * bar.x, 1u, __ATOMIC_RELAXED, __HIP_MEMORY_SCOPE_AGENT);
    F.wgv = F.wg;

    PHASE_BEGIN(0)
    p0_prologue(F);
    PHASE_END(0)
    {
        volatile LAS unsigned* misc = (volatile LAS unsigned*)(F.lds + MISC_OFF);
        if (F.tid == 0) { bool even = (F.G % 8) == 0; for (int j = 0; j < 8; ++j) even = even && (__hip_atomic_load(F.ctl + CW_XRANK + 16 * j, __ATOMIC_RELAXED, __HIP_MEMORY_SCOPE_AGENT) == (unsigned)(F.G / 8));
            misc[1] = (even && bar.x < 8u) ? bar.x + 8u * misc[0] : (unsigned)F.wg; }
        __syncthreads();
        F.wgv = __builtin_amdgcn_readfirstlane((int)misc[1]);
    }
    PHASE_BEGIN(1)
    { constexpr int FFN_END = P0_I_OUT + 2 * P0_I_G + P0_I_D;
      const int GG = F.G == 256 ? F.G - 8 : F.G;
      if (F.wgv >= GG) convert_items_pipelined(F, FFN_END - P0_MOVED - P1_DED, FFN_END - P0_MOVED, (F.wgv - GG) * NWAVES + F.wave, (F.G - GG) * NWAVES);
      else {
      pg8::Gemm g{F.HN, F.WIN, M, NPAD, DM}; pg8::StaticOrder S; S.init(M, NPAD, GG, F.wgv, GWGM_P1); pg8::EpiProj E{F.PROJ, F.GLR, (float*)(F.ctl + CW_VST)};
      pg8::gemm_phase<pg8::EpiProj, pg8::StaticOrder, ALIGN_P1, GEMM_SP2>(F.lds, g, S, E);
      { const int nwg = (M / 256) * (NPAD / 256), full = nwg / GG, T = nwg - full * GG, nidle = T > 0 ? GG - T : GG, rank = T > 0 ? F.wgv - T : F.wgv;
        if (rank >= 0) convert_items(F, FFN_END - P0_MOVED, FFN_END, rank * NWAVES + F.wave, nidle * NWAVES); } } }
    PHASE_END(1)
    PHASE_BEGIN(2)
#pragma unroll
    for (int rp = 0; rp < 1; ++rp) { for (int m = MP + gw; m < M; m += NGW) ln_sample_row(F, m); }
#pragma unroll
    for (int rp = 0; rp < 1; ++rp) { for (int u = F.wg; u < 2 * NBH; u += F.G) { if (u < NBH) gla_prep_unit(F, u); else v_transpose_unit(F, u - NBH); } }
    PHASE_END(2)
    PHASE_BEGIN(3)
#pragma unroll
    for (int rp = 0; rp < 1; ++rp) { for (int u = F.wgv; u < NG * 32; u += F.G) chain_pass1_unit(F, u); }
    PHASE_END(3)
    PHASE_BEGIN(4)
#pragma unroll
    for (int rp = 0; rp < 1; ++rp) { for (int u = F.wgv; u < NG * 32; u += F.G) chain_pass2_prompt_unit(F, u); }
#pragma unroll
    for (int rp = 0; rp < 1; ++rp) { for (int u = F.wgv; u < 32 * 32; u += F.G) chain_sample_unit(F, u); }
    PHASE_END(4)
    PHASE_BEGIN(5)
    gla_finish_rows(F, gw, NGW);
    __syncthreads();
#pragma unroll
    for (int rp = 0; rp < 1; ++rp) { SguPre sp; SguW sw; sw.a = -1; if (F.wg < 160 * 16) sgu_prefetch(F, F.wg, sp); for (int u = F.wg; u < 160 * 16; u += F.G) sgu_unit(F, u, sp, u + F.G < 160 * 16 ? u + F.G : -1, sw); }
    PHASE_END(5)
    PHASE_BEGIN(6)
    { int rounds, T, P; pg8::split_plan((M / 256) * (DM / 256), F.G, 4, rounds, T, P);
      pg8::Gemm g{F.MIX, F.WOUT, M, DM, DM}; pg8::StaticOrder S; S.init(M, DM, F.G, F.wgv, GWGM); S.imax = rounds; pg8::EpiResidNorm E{F.x_prompt, F.x_sample, MP, F.out, F.HN, F.g_ffn, (float*)(F.ctl + CW_SSQ)};
      pg8::gemm_phase<pg8::EpiResidNorm, pg8::StaticOrder, ALIGN_P6, GEMM_SP2>(F.lds, g, S, E);
      if (T > 0) { pg8::Gemm g2{F.MIX, F.WOUT, M, DM, DM / P, DM}; pg8::TailOrder TO; TO.init(M, DM, F.G, F.wgv, GWGM); TO.base = rounds * F.G; TO.T = T; TO.P = P;
          pg8::EpiPublish E2; E2.slab = (float*)(args.ws + WS_SLAB); E2.flags = F.ctl + CW_FLAG + 4096 * 0; E2.nparts = P;
          pg8::gemm_phase<pg8::EpiPublish, pg8::TailOrder, true, GEMM_SP2>(F.lds, g2, TO, E2);
          pg8::tail_combine(TO, E, E2.slab, E2.flags, P); } }
    PHASE_END(6)
    PHASE_BEGIN(8)
    { int rounds, T, P; pg8::split_plan((M / 256) * (2 * DFF / 256), F.G, 4, rounds, T, P);
      pg8::Gemm g{F.HN, F.WGU, M, 2 * DFF, DM}; pg8::StaticOrder S; S.init(M, 2 * DFF, F.G, F.wgv, GWGM); S.imax = rounds; pg8::EpiSwiglu E{F.HFF, (const float*)(F.ctl + CW_SSQ)};
      pg8::gemm_phase<pg8::EpiSwiglu, pg8::StaticOrder, ALIGN_P8, GEMM_SP2>(F.lds, g, S, E);
      if (T > 0) { pg8::Gemm g2{F.HN, F.WGU, M, 2 * DFF, DM / P, DM}; pg8::TailOrder TO; TO.init(M, 2 * DFF, F.G, F.wgv, GWGM); TO.base = rounds * F.G; TO.T = T; TO.P = P;
          pg8::EpiPublish E2{(float*)(args.ws + WS_SLAB), F.ctl + CW_FLAG + 4096 * 1, P};
          pg8::gemm_phase<pg8::EpiPublish, pg8::TailOrder, true, GEMM_SP2>(F.lds, g2, TO, E2);
          pg8::tail_combine(TO, E, E2.slab, E2.flags, P); } }
    PHASE_END(8)
    PHASE_BEGIN(9)
    { int rounds, T, P; pg8::split_plan((M / 256) * (DM / 256), F.G, 2, rounds, T, P);
      pg8::Gemm g{F.HFF, F.WDN, M, DM, DFF}; pg8::StaticOrder S; S.init(M, DM, F.G, F.wgv, P9_WGM); S.imax = rounds; pg8::EpiResidFinal E{F.HN, F.g_ffn, (float*)(F.ctl + CW_SSQ2)};
      pg8::gemm_phase<pg8::EpiResidFinal, pg8::StaticOrder, ALIGN_P6, GEMM_SP2>(F.lds, g, S, E);
      if (T > 0) { pg8::Gemm g2{F.HFF, F.WDN, M, DM, DFF / P, DFF}; pg8::TailOrder TO; TO.init(M, DM, F.G, F.wgv, P9_WGM); TO.base = rounds * F.G; TO.T = T; TO.P = P;
          pg8::EpiPublish E2; E2.slab = (float*)(args.ws + WS_SLAB); E2.flags = F.ctl + CW_FLAG + 4096 * 2; E2.nparts = P;
          pg8::gemm_phase<pg8::EpiPublish, pg8::TailOrder, true, GEMM_SP2>(F.lds, g2, TO, E2);
          pg8::tail_combine(TO, E, E2.slab, E2.flags, P); } }
    PHASE_END(9)
    PHASE_BEGIN(10)
    final_norm_rows(F, gw, NGW);
    }
}

extern "C" void kernel_launch(void* const* d_in, const int* in_sizes, int n_in, void* d_out, int out_size, void* d_ws, size_t ws_size, hipStream_t stream) {
    static int grid = 0;
    if (grid == 0) {
        if (n_in != 18 || (size_t)out_size != O_END || ws_size < WS_END) { fprintf(stderr, "kernel_launch: unexpected shapes (n_in %d, out %d, ws %zu < %zu); nothing launched\n", n_in, out_size, ws_size, (size_t)WS_END); grid = -1; return; }
        int dev = 0, cus = 0, per_cu = 0;
        if (hipGetDevice(&dev) != hipSuccess || hipDeviceGetAttribute(&cus, hipDeviceAttributeMultiprocessorCount, dev) != hipSuccess) { grid = -1; return; }
        if (hipFuncSetAttribute((const void*)fwd_kernel, hipFuncAttributeMaxDynamicSharedMemorySize, LDS_BYTES) != hipSuccess) { fprintf(stderr, "kernel_launch: hipFuncSetAttribute failed\n"); grid = -1; return; }
        if (hipOccupancyMaxActiveBlocksPerMultiprocessor(&per_cu, (const void*)fwd_kernel, NWAVES * 64, LDS_BYTES) != hipSuccess || per_cu < 1)
            fprintf(stderr, "kernel_launch: note: occupancy query reports %d workgroups per CU\n", per_cu);
        (void)hipGetLastError();
        grid = cus;
    }
    if (grid < 0) return;
    if (hipMemsetAsync((char*)d_ws + WS_CTL, 0, CTL_ZERO_BYTES, stream) != hipSuccess) return;
    Args a{};
    for (int i = 0; i < 18; ++i) a.in[i] = (const float*)d_in[i];
    a.out = (float*)d_out; a.ws = (unsigned char*)d_ws;
    hipLaunchKernelGGL(fwd_kernel, dim3(grid), dim3(NWAVES * 64), LDS_BYTES, stream, a);
}
```
